# Optimizing an MI355X kernel written in HIP

```python
import functools
import jax
import jax.numpy as jnp
from jax import lax
import numpy as np

D_MODEL = 2048
BATCH = 4
SEQ = 2048
DEPTH = 2

CTX_LEN = 256
GRID_W = 64
CHUNK = 128
NORM_EPS = 1e-6
ROPE_BASE = 10000.0

RET_HEADS = 4
RET_DK = 128
RET_DV = 256
HGRN_HEADS = 4
HGRN_DK = 128
HGRN_DV = 128
MLSTM_HEADS = 4
MLSTM_DK = 128
MLSTM_DV = 128
MLSTM_CONV = 3

RET_QK = RET_HEADS * RET_DK
RET_WIDTH = RET_HEADS * RET_DV
HGRN_QK = HGRN_HEADS * HGRN_DK
HGRN_WIDTH = HGRN_HEADS * HGRN_DV
MLSTM_QK = MLSTM_HEADS * MLSTM_DK
MLSTM_WIDTH = MLSTM_HEADS * MLSTM_DV
MIX_WIDTH = RET_WIDTH + HGRN_WIDTH + MLSTM_WIDTH
MLSTM_GATES = 4 * MLSTM_HEADS

PROJ_SPLITS = (
    RET_QK, RET_QK, RET_WIDTH, RET_WIDTH,
    HGRN_QK, HGRN_QK, HGRN_QK, HGRN_WIDTH, HGRN_WIDTH,
    MLSTM_QK, MLSTM_QK, MLSTM_WIDTH, MLSTM_WIDTH, MLSTM_GATES,
)
PROJ_COLS = sum(PROJ_SPLITS)

D_FF = 5632
N_EXPERTS = 8
TOP_K = 2
D_FF_EXPERT = 5632
MOE_BLOCK = 128
N_DENSE = (DEPTH + 1) // 2
N_MOE = DEPTH // 2

kernel_name = "hybrid_ret_hgrn2_mlstm_moe_dit_block"


def rmsnorm(x, g):
    xf = x.astype(jnp.float32)
    y = xf * lax.rsqrt(jnp.mean(xf * xf, axis=-1, keepdims=True) + NORM_EPS)
    return (y * g.astype(jnp.float32)).astype(x.dtype)


def head_norm(y, g, n_heads, center):
    B, L, W = y.shape
    yh = y.astype(jnp.float32).reshape(B, L, n_heads, W // n_heads)
    if center:
        yh = yh - jnp.mean(yh, axis=-1, keepdims=True)
    yh = yh * lax.rsqrt(jnp.mean(yh * yh, axis=-1, keepdims=True) + NORM_EPS)
    return yh.reshape(B, L, W) * g.astype(jnp.float32)


def split_heads(t, n_heads):
    B, L, W = t.shape
    return t.reshape(B, L, n_heads, W // n_heads).transpose(0, 2, 1, 3).astype(jnp.float32)


def merge_heads(t):
    B, H, L, d = t.shape
    return t.transpose(0, 2, 1, 3).reshape(B, L, H * d)


def to_chunks(t):
    B, H, L = t.shape[:3]
    t = t.reshape((B, H, L // CHUNK, CHUNK) + t.shape[3:])
    return jnp.moveaxis(t, 2, 0)


def from_chunks(t):
    t = jnp.moveaxis(t, 0, 2)
    return t.reshape((t.shape[0], t.shape[1], -1) + t.shape[4:])


def flip_seq(t):
    return jnp.flip(t, axis=2)


def axial_rotary_tables(n_tokens):
    rows = n_tokens // GRID_W
    row = jnp.repeat(jnp.arange(rows, dtype=jnp.float32), GRID_W)
    col = jnp.tile(jnp.arange(GRID_W, dtype=jnp.float32), rows)
    n_freq = RET_DK // 4
    inv = ROPE_BASE ** (-jnp.arange(n_freq, dtype=jnp.float32) / n_freq)
    ang = jnp.concatenate([row[:, None] * inv, col[:, None] * inv], axis=-1)
    return jnp.cos(ang), jnp.sin(ang)


def apply_rotary(t, cos, sin):
    t1, t2 = jnp.split(t, 2, axis=-1)
    return jnp.concatenate([t1 * cos - t2 * sin, t2 * cos + t1 * sin], axis=-1)


def dwconv_centred(x, w):
    return lax.conv_general_dilated(
        x, w.astype(x.dtype)[:, None, :], window_strides=(1,), padding="SAME",
        dimension_numbers=("NWC", "WIO", "NWC"), feature_group_count=x.shape[-1])


def retention_scan(args, state, log_g):
    q, k, v = args
    pos = jnp.arange(CHUNK, dtype=jnp.float32)
    rel = pos[:, None] - pos[None, :]
    lg = log_g[:, None, None]
    dmat = jnp.where(rel >= 0, jnp.exp(jnp.maximum(rel, 0.0)[None] * lg), 0.0)
    dec_q = jnp.exp((pos + 1.0)[None, :] * log_g[:, None])[..., None]
    dec_k = jnp.exp((CHUNK - 1.0 - pos)[None, :] * log_g[:, None])[..., None]
    dec_s = jnp.exp(CHUNK * log_g)[:, None, None]

    def step(S, xs):
        qc, kc, vc = xs
        a = jnp.einsum("bhtd,bhsd->bhts", qc, kc) * dmat
        o = jnp.einsum("bhts,bhse->bhte", a, vc) + jnp.einsum("bhtd,bhde->bhte", qc * dec_q, S)
        S = dec_s * S + jnp.einsum("bhsd,bhse->bhde", kc * dec_k, vc)
        return S, o

    S, o = lax.scan(step, state, [to_chunks(q), to_chunks(k), to_chunks(v)])
    return from_chunks(o), S


def gla_scan(args, state):
    q, k, v, lf = args
    tril = jnp.tril(jnp.ones((CHUNK, CHUNK), dtype=bool))

    def step(S, xs):
        qc, kc, vc, lfc = xs
        b = jnp.cumsum(lfc, axis=-2)
        diff = jnp.where(tril[:, :, None], b[..., :, None, :] - b[..., None, :, :], -jnp.inf)
        a = jnp.sum(qc[..., :, None, :] * kc[..., None, :, :] * jnp.exp(diff), axis=-1)
        o = jnp.einsum("bhts,bhse->bhte", a, vc) + jnp.einsum("bhtd,bhde->bhte", qc * jnp.exp(b), S)
        b_last = b[..., -1:, :]
        S = jnp.exp(b_last[..., 0, :])[..., None] * S + jnp.einsum("bhsd,bhse->bhde", kc * jnp.exp(b_last - b), vc)
        return S, o

    S, o = lax.scan(step, state, [to_chunks(q), to_chunks(k), to_chunks(v), to_chunks(lf)])
    return from_chunks(o), S


def mlstm_scan(args, state):
    q, k, v, ig, lf = args
    tril = jnp.tril(jnp.ones((CHUNK, CHUNK), dtype=bool))

    def step(carry, xs):
        C, n, m = carry
        qc, kc, vc, igc, lfc = xs
        b = jnp.cumsum(lfc, axis=-1)
        dmat = jnp.where(tril, b[..., :, None] - b[..., None, :] + igc[..., None, :], -jnp.inf)
        m_inter = b + m[..., None]
        m_t = jnp.maximum(jnp.max(dmat, axis=-1), m_inter)
        w_intra = jnp.exp(dmat - m_t[..., None])
        w_inter = jnp.exp(m_inter - m_t)
        a = jnp.einsum("bhtd,bhsd->bhts", qc, kc) * w_intra
        num = jnp.einsum("bhts,bhse->bhte", a, vc) + w_inter[..., None] * jnp.einsum("bhtd,bhde->bhte", qc, C)
        den = jnp.sum(a, axis=-1) + w_inter * jnp.einsum("bhtd,bhd->bht", qc, n)
        h = num / jnp.maximum(jnp.abs(den), jnp.exp(-m_t))[..., None]
        b_last = b[..., -1]
        m_new = jnp.maximum(b_last + m, jnp.max(b_last[..., None] - b + igc, axis=-1))
        w_s = jnp.exp(b_last[..., None] - b + igc - m_new[..., None])
        decay = jnp.exp(b_last + m - m_new)
        kw = kc * w_s[..., None]
        C = decay[..., None, None] * C + jnp.einsum("bhsd,bhse->bhde", kw, vc)
        n = decay[..., None] * n + jnp.sum(kw, axis=-2)
        return (C, n, m_new), h

    xs = [to_chunks(q), to_chunks(k), to_chunks(v), to_chunks(ig), to_chunks(lf)]
    state, h = lax.scan(step, state, xs)
    return from_chunks(h), state


def run_bidirectional(scan_f, scan_b, ctx_f, lat_f, ctx_b, lat_b, init):
    oc_f, s_f = scan_f(ctx_f, init)
    ol_f, _ = scan_f(lat_f, s_f)
    oc_b, s_b = scan_b([flip_seq(t) for t in ctx_b], init)
    ol_b, _ = scan_b([flip_seq(t) for t in lat_b], s_b)
    return oc_f + flip_seq(oc_b), ol_f + flip_seq(ol_b)


def token_mixers(pc, pl, cos, sin, layer, ret_decay, hgrn_lb, ret_gn, hgrn_gn,
                 mlstm_conv, mlstm_gate_b, mlstm_gn):
    f32 = jnp.float32
    B = pl.shape[0]
    offsets = [int(o) for o in np.cumsum(PROJ_SPLITS)[:-1]]
    pcs = jnp.split(pc, offsets, axis=-1)
    pls = jnp.split(pl, offsets, axis=-1)

    def ret_args(ps, rotate):
        q = split_heads(ps[0], RET_HEADS)
        k = split_heads(ps[1], RET_HEADS) * RET_DK ** -0.5
        if rotate:
            q = apply_rotary(q, cos, sin)
            k = apply_rotary(k, cos, sin)
        return [q, k, split_heads(ps[2], RET_HEADS)]

    log_g = jax.nn.log_sigmoid(ret_decay.astype(f32))
    rc, rl = ret_args(pcs, False), ret_args(pls, True)
    ret_c, ret_l = run_bidirectional(
        functools.partial(retention_scan, log_g=log_g[0]),
        functools.partial(retention_scan, log_g=log_g[1]),
        rc, rl, rc, rl, jnp.zeros((B, RET_HEADS, RET_DK, RET_DV), f32))

    def ret_out(o, ps):
        return head_norm(merge_heads(o), ret_gn, RET_HEADS, False) * jax.nn.silu(ps[3].astype(f32))

    sm = jax.nn.softmax(hgrn_lb.astype(f32), axis=0)
    lb = jnp.clip(jnp.cumsum(sm, axis=0)[layer] - sm[0], 0.0, 1.0)
    log_lb, log_ub = jnp.log(lb), jnp.log1p(-lb)

    def hgrn_args(ps):
        q = jax.nn.silu(split_heads(ps[4], HGRN_HEADS))
        i = split_heads(ps[7], HGRN_HEADS)
        dirs = []
        for f_raw in (ps[5], ps[6]):
            lf = jnp.logaddexp(log_lb, log_ub + jax.nn.log_sigmoid(f_raw.astype(f32)))
            lf = split_heads(lf, HGRN_HEADS)
            dirs.append([q, -jnp.expm1(lf), i, lf])
        return dirs

    hcf, hcb = hgrn_args(pcs)
    hlf, hlb = hgrn_args(pls)
    hg_c, hg_l = run_bidirectional(gla_scan, gla_scan, hcf, hlf, hcb, hlb,
                                   jnp.zeros((B, HGRN_HEADS, HGRN_DK, HGRN_DV), f32))

    def hgrn_out(o, ps):
        return head_norm(merge_heads(o), hgrn_gn, HGRN_HEADS, False) * jax.nn.silu(ps[8].astype(f32))

    def mlstm_args(ps):
        qk = jax.nn.silu(dwconv_centred(jnp.concatenate([ps[9], ps[10]], axis=-1), mlstm_conv))
        q = split_heads(qk[..., :MLSTM_QK], MLSTM_HEADS)
        k = split_heads(qk[..., MLSTM_QK:], MLSTM_HEADS) * MLSTM_DK ** -0.5
        v = split_heads(ps[11], MLSTM_HEADS)
        gates = jnp.swapaxes(ps[13].astype(f32) + mlstm_gate_b.astype(f32), 1, 2)
        ig_f, ig_b, fg_f, fg_b = jnp.split(gates, 4, axis=1)
        return ([q, k, v, ig_f, jax.nn.log_sigmoid(fg_f)],
                [q, k, v, ig_b, jax.nn.log_sigmoid(fg_b)])

    mcf, mcb = mlstm_args(pcs)
    mlf, mlb = mlstm_args(pls)
    m_init = (jnp.zeros((B, MLSTM_HEADS, MLSTM_DK, MLSTM_DV), f32),
              jnp.zeros((B, MLSTM_HEADS, MLSTM_DK), f32),
              jnp.zeros((B, MLSTM_HEADS), f32))
    ml_c, ml_l = run_bidirectional(mlstm_scan, mlstm_scan, mcf, mlf, mcb, mlb, m_init)

    def mlstm_out(o, ps):
        return head_norm(merge_heads(o), mlstm_gn, MLSTM_HEADS, True) * jax.nn.sigmoid(ps[12].astype(f32))

    mix_c = jnp.concatenate([ret_out(ret_c, pcs), hgrn_out(hg_c, pcs), mlstm_out(ml_c, pcs)], axis=-1)
    mix_l = jnp.concatenate([ret_out(ret_l, pls), hgrn_out(hg_l, pls), mlstm_out(ml_l, pls)], axis=-1)
    return mix_c.astype(pc.dtype), mix_l.astype(pl.dtype)


def swiglu(h, w1, w3, w2):
    return (jax.nn.silu(h @ w1) * (h @ w3)) @ w2


def moe_swiglu(xt, w_router, w1, w3, w2):
    T, D = xt.shape
    logits = (xt @ w_router).astype(jnp.float32)
    top_val, top_idx = lax.top_k(logits, TOP_K)
    gates = jax.nn.softmax(top_val, axis=-1)
    n_assign = T * TOP_K
    flat_e = top_idx.reshape(-1)
    flat_tok = jnp.arange(n_assign, dtype=jnp.int32) // TOP_K
    order = jnp.argsort(flat_e)
    sorted_e = flat_e[order]
    counts = jnp.bincount(flat_e, length=N_EXPERTS)
    padded = (counts + MOE_BLOCK - 1) // MOE_BLOCK * MOE_BLOCK
    pad_end = jnp.cumsum(padded)
    pad_start = pad_end - padded
    start = jnp.cumsum(counts) - counts
    dest = pad_start[sorted_e] + jnp.arange(n_assign, dtype=jnp.int32) - start[sorted_e]
    n_blocks = -(-n_assign // MOE_BLOCK) + N_EXPERTS
    n_slots = n_blocks * MOE_BLOCK
    slot_tok = jnp.full((n_slots,), T, dtype=jnp.int32).at[dest].set(flat_tok[order])
    slot_gate = jnp.zeros((n_slots,), jnp.float32).at[dest].set(gates.reshape(-1)[order])
    block_e = jnp.minimum(
        jnp.searchsorted(pad_end, jnp.arange(n_blocks, dtype=jnp.int32) * MOE_BLOCK, side="right"),
        N_EXPERTS - 1)
    x_pad = jnp.concatenate([xt, jnp.zeros((1, D), xt.dtype)], axis=0)
    xb = x_pad[slot_tok].reshape(n_blocks, MOE_BLOCK, D)

    def expert_block(args):
        xblk, e = args
        return swiglu(xblk, w1[e], w3[e], w2[e])

    yb = lax.map(expert_block, (xb, block_e))
    y = jnp.zeros((T + 1, D), jnp.float32).at[slot_tok].add(
        yb.reshape(n_slots, D).astype(jnp.float32) * slot_gate[:, None])
    return y[:T].astype(xt.dtype)


def setup_inputs(seed: int = 0) -> dict:
    key = jax.random.key(seed)
    ks = jax.random.split(key, 24)
    f32 = jnp.float32

    def nrm(k, shape, scale):
        return scale * jax.random.normal(k, shape, f32)

    H = MLSTM_HEADS
    ret_base = jnp.log(2.0 ** (5.0 + jnp.arange(RET_HEADS, dtype=f32)) - 1.0)
    f_base = jnp.tile(jnp.linspace(3.0, 6.0, H, dtype=f32), 2)[None]
    return {
        "x": nrm(ks[0], (BATCH, SEQ, D_MODEL), 1.0),
        "c": nrm(ks[1], (BATCH, D_MODEL), 1.0),
        "ctx": nrm(ks[2], (BATCH, CTX_LEN, D_MODEL), 1.0),
        "c_ctx": nrm(ks[3], (D_MODEL,), 1.0),
        "w_ada": nrm(ks[4], (DEPTH, D_MODEL, 6 * D_MODEL), 0.5 * D_MODEL ** -0.5),
        "b_ada": nrm(ks[5], (DEPTH, 6 * D_MODEL), 0.02),
        "norm_g": 1.0 + nrm(ks[6], (DEPTH, 4, D_MODEL), 0.05),
        "w_in": nrm(ks[7], (DEPTH, D_MODEL, PROJ_COLS), D_MODEL ** -0.5),
        "w_out": nrm(ks[8], (DEPTH, MIX_WIDTH, D_MODEL), MIX_WIDTH ** -0.5),
        "ret_decay": ret_base + nrm(ks[9], (DEPTH, 2, RET_HEADS), 0.1),
        "ret_gn": 1.0 + nrm(ks[10], (DEPTH, RET_WIDTH), 0.05),
        "hgrn_lb": nrm(ks[11], (DEPTH, HGRN_QK), 1.0),
        "hgrn_gn": 1.0 + nrm(ks[12], (DEPTH, HGRN_WIDTH), 0.05),
        "mlstm_conv": nrm(ks[13], (DEPTH, MLSTM_CONV, 2 * MLSTM_QK), MLSTM_CONV ** -0.5),
        "mlstm_gate_b": jnp.concatenate(
            [nrm(ks[14], (DEPTH, 2 * H), 0.1), f_base + nrm(ks[15], (DEPTH, 2 * H), 0.1)], axis=-1),
        "mlstm_gn": 1.0 + nrm(ks[16], (DEPTH, MLSTM_WIDTH), 0.05),
        "w_ffn1": nrm(ks[17], (N_DENSE, D_MODEL, D_FF), D_MODEL ** -0.5),
        "w_ffn3": nrm(ks[18], (N_DENSE, D_MODEL, D_FF), D_MODEL ** -0.5),
        "w_ffn2": nrm(ks[19], (N_DENSE, D_FF, D_MODEL), D_FF ** -0.5),
        "w_router": nrm(ks[20], (N_MOE, D_MODEL, N_EXPERTS), D_MODEL ** -0.5),
        "w_exp1": nrm(ks[21], (N_MOE, N_EXPERTS, D_MODEL, D_FF_EXPERT), D_MODEL ** -0.5),
        "w_exp3": nrm(ks[22], (N_MOE, N_EXPERTS, D_MODEL, D_FF_EXPERT), D_MODEL ** -0.5),
        "w_exp2": nrm(ks[23], (N_MOE, N_EXPERTS, D_FF_EXPERT, D_MODEL), D_FF_EXPERT ** -0.5),
    }


def reference(x, c, ctx, c_ctx, w_ada, b_ada, norm_g, w_in, w_out, ret_decay, ret_gn,
              hgrn_lb, hgrn_gn, mlstm_conv, mlstm_gate_b, mlstm_gn,
              w_ffn1, w_ffn3, w_ffn2, w_router, w_exp1, w_exp3, w_exp2):
    B, L, D = x.shape
    Lc = ctx.shape[1]
    cos, sin = axial_rotary_tables(L)
    xc = ctx
    s_lat = jax.nn.silu(c)
    s_ctx = jax.nn.silu(c_ctx)
    for layer in range(DEPTH):
        last = layer == DEPTH - 1
        mod = (s_lat @ w_ada[layer] + b_ada[layer]).reshape(B, 6, 1, D)
        modc = (s_ctx @ w_ada[layer] + b_ada[layer]).reshape(6, D)
        g = norm_g[layer]

        hl = rmsnorm(x, g[0]) * (1.0 + mod[:, 1]) + mod[:, 0]
        hc = rmsnorm(xc, g[0]) * (1.0 + modc[1]) + modc[0]
        p = jnp.concatenate([hc, hl], axis=1) @ w_in[layer]
        mix_c, mix_l = token_mixers(p[:, :Lc], p[:, Lc:], cos, sin, layer, ret_decay[layer], hgrn_lb,
                                    ret_gn[layer], hgrn_gn[layer], mlstm_conv[layer],
                                    mlstm_gate_b[layer], mlstm_gn[layer])
        if last:
            x = x + mod[:, 2] * rmsnorm(mix_l @ w_out[layer], g[1])
        else:
            y = rmsnorm(jnp.concatenate([mix_c, mix_l], axis=1) @ w_out[layer], g[1])
            xc = xc + modc[2] * y[:, :Lc]
            x = x + mod[:, 2] * y[:, Lc:]

        hl = rmsnorm(x, g[2]) * (1.0 + mod[:, 4]) + mod[:, 3]
        if last:
            h = hl
        else:
            hc = rmsnorm(xc, g[2]) * (1.0 + modc[4]) + modc[3]
            h = jnp.concatenate([hc, hl], axis=1)
        j = layer // 2
        if layer % 2 == 0:
            f = swiglu(h, w_ffn1[j], w_ffn3[j], w_ffn2[j])
        else:
            f = moe_swiglu(h.reshape(-1, D), w_router[j], w_exp1[j], w_exp3[j], w_exp2[j]).reshape(h.shape)
        f = rmsnorm(f, g[3])
        if last:
            x = x + mod[:, 5] * f
        else:
            xc = xc + modc[5] * f[:, :Lc]
            x = x + mod[:, 5] * f[:, Lc:]
    return x
```

```cpp
#include <hip/hip_runtime.h>
#include <cstdio>
#include <cstdint>
namespace pg8 {
#define PG8_LAS __attribute__((address_space(3)))
typedef unsigned short bf16_t;
typedef short bf16x8 __attribute__((ext_vector_type(8)));
typedef float f32x4 __attribute__((ext_vector_type(4)));
typedef unsigned u32x4 __attribute__((ext_vector_type(4)));
constexpr int BM = 256, BK = 64, HALF = 128, HTB = HALF * BK * 2  , STAGE_BYTES = 8 * HTB, NXCD = 8, WGM = 8;

__host__ __device__ __forceinline__ int lds_byte(int r, int c) { const int st = (r >> 4) * 2 + (c >> 5), rr = r & 15, cc = c & 31, ob = rr * 64 + cc * 2; return st * 1024 + (ob ^ (((ob >> 9) & 1) << 5)); }
__host__ __device__ __forceinline__ void stage_rc(int b, int& R, int& C) { const int st = b / 1024, sb = b % 1024, swz = sb ^ (((sb >> 9) & 1) << 5); R = (st >> 1) * 16 + swz / 64; C = (st & 1) * 32 + (swz % 64) / 2; }
__host__ __device__ __forceinline__ int perm32(int rho) { const int n = rho >> 4, i = rho & 15; return 8 * (i >> 2) + 4 * n + (i & 3); }


struct Unit { int pm, pn, po; };
struct Gemm { const bf16_t* A; const bf16_t* Bt; int M, N, K; };
__device__ __forceinline__ unsigned cvt_pk_bf16(float lo, float hi) { unsigned r; asm volatile("v_cvt_pk_bf16_f32 %0, %1, %2" : "=v"(r) : "v"(lo), "v"(hi)); return r; }

struct TileOrder {
    int mode, nM, nN, nwg, G, c, NT; const PG8_LAS int* tab;
    __device__ __forceinline__ void init_static(int M, int N, int G_, int c_) { mode = 0; nM = M / BM; nN = N / BM; nwg = nM * nN; G = G_; c = c_; NT = 0; tab = nullptr; }
    __device__ __forceinline__ void init_latent(int G_, int c_) { mode = 1; nM = 32; nN = 8; nwg = 256; G = G_; c = c_; NT = 0; tab = nullptr; }
    __device__ __forceinline__ void init_moe(const PG8_LAS int* tab_, int NT_, int G_, int c_) { mode = 2; tab = tab_; NT = NT_; nM = 0; nN = NT_; nwg = tab_[24] * NT_; G = G_; c = c_; }
    __device__ __forceinline__ bool next(int i, Unit& u) const {
        const long L = (long)i * G + c; if (L >= nwg) return false;
        if (mode == 0) {
            int wgid = (int)L; { const int q = nwg / NXCD, r = nwg % NXCD, xcd = wgid % NXCD, off = wgid / NXCD; wgid = (xcd < r ? xcd * (q + 1) : r * (q + 1) + (xcd - r) * q) + off; }
            const int nig = WGM * nN, gid = wgid / nig, fm = gid * WGM, gsz = (nM - fm) < WGM ? (nM - fm) : WGM;
            u.pm = fm + ((wgid % nig) % gsz); u.pn = (wgid % nig) / gsz; u.po = u.pn; return true;
        } else if (mode == 1) {
            const int l = (int)L, idx = l & 31; u.pn = l >> 5; u.po = u.pn; u.pm = 9 * (idx >> 3) + 1 + (idx & 7); return true;
        } else {
            const int l = (int)L; int e = 0;
#pragma unroll
            for (int j = 1; j < 8; ++j) if (l >= tab[16 + j] * NT) e = j;
            const int idx = l - tab[16 + e] * NT, te = tab[e], pml = idx % te, pnl = idx / te;
            u.pm = tab[8 + e] + pml; u.pn = e * NT + pnl; u.po = pnl; return true;
        }
    }
    __device__ __forceinline__ void a_ready(const Unit&) const {}
    __device__ __forceinline__ void done(const Unit&) const {}
};

struct EpiF32 {
    static constexpr bool PERM = false, AFTER_DRAIN = false;
    float* C; int ldc;
    __device__ __forceinline__ void operator()(const f32x4 (&acc)[2][2][4][2], const Unit& u, int wr, int wc, int fr, int fq) const {
        const int row0 = u.pm * BM + wr * 64 + fr, col0 = u.po * BM + wc * 32 + 4 * fq;
#pragma unroll
        for (int ai = 0; ai < 2; ++ai)
#pragma unroll
            for (int m = 0; m < 4; ++m) { float* rowp = C + (size_t)(row0 + ai * HALF + m * 16) * ldc + col0;
#pragma unroll
                for (int bj = 0; bj < 2; ++bj)
#pragma unroll
                    for (int n = 0; n < 2; ++n) *(f32x4*)(rowp + bj * HALF + n * 16) = acc[ai][bj][m][n]; }
    }
};
struct EpiBf16 {
    static constexpr bool PERM = true, AFTER_DRAIN = false;
    bf16_t* O; int ldc;
    __device__ __forceinline__ void operator()(const f32x4 (&acc)[2][2][4][2], const Unit& u, int wr, int wc, int fr, int fq) const {
        const int row0 = u.pm * BM + wr * 64 + fr, col0 = u.po * BM + wc * 32 + 8 * fq;
#pragma unroll
        for (int ai = 0; ai < 2; ++ai)
#pragma unroll
            for (int m = 0; m < 4; ++m) { bf16_t* rowp = O + (size_t)(row0 + ai * HALF + m * 16) * ldc + col0;
#pragma unroll
                for (int bj = 0; bj < 2; ++bj) { const f32x4 v0 = acc[ai][bj][m][0], v1 = acc[ai][bj][m][1];
                    u32x4 w; w.x = cvt_pk_bf16(v0[0], v0[1]); w.y = cvt_pk_bf16(v0[2], v0[3]); w.z = cvt_pk_bf16(v1[0], v1[1]); w.w = cvt_pk_bf16(v1[2], v1[3]);
                    *(u32x4*)(rowp + bj * HALF) = w; } }
    }
};
struct EpiSwiGLU {
    static constexpr bool PERM = true, AFTER_DRAIN = false;
    bf16_t* O; int ldc;
    __device__ __forceinline__ void operator()(const f32x4 (&acc)[2][2][4][2], const Unit& u, int wr, int wc, int fr, int fq) const {
        const int row0 = u.pm * BM + wr * 64 + fr, col0 = u.po * HALF + wc * 32 + 8 * fq;
#pragma unroll
        for (int ai = 0; ai < 2; ++ai)
#pragma unroll
            for (int m = 0; m < 4; ++m) { bf16_t* rowp = O + (size_t)(row0 + ai * HALF + m * 16) * ldc + col0;
                float o[8];
#pragma unroll
                for (int n = 0; n < 2; ++n)
#pragma unroll
                    for (int j = 0; j < 4; ++j) { const float a = acc[ai][0][m][n][j], b = acc[ai][1][m][n][j]; o[4 * n + j] = a * __builtin_amdgcn_rcpf(1.0f + __expf(-a)) * b; }
                u32x4 w; w.x = cvt_pk_bf16(o[0], o[1]); w.y = cvt_pk_bf16(o[2], o[3]); w.z = cvt_pk_bf16(o[4], o[5]); w.w = cvt_pk_bf16(o[6], o[7]);
                *(u32x4*)rowp = w; }
    }
};
template <class Epi, class Sched, bool ALIGN_EPI = false, bool SP2 = false>
__device__ __forceinline__ void gemm_phase(PG8_LAS unsigned char* lds, const Gemm g, const Sched& S, const Epi& E) {
    int tid0 = threadIdx.x; asm volatile("" : "+v"(tid0));
    const int tid = tid0, wid = __builtin_amdgcn_readfirstlane(tid >> 6), lane = tid & 63, wr = wid >> 2, wc = wid & 3, fr = lane & 15, fq = lane >> 4;
    const int K = g.K, nt = K / BK;
    unsigned voffA[2], voffB[2];
#pragma unroll
    for (int i = 0; i < 2; ++i) { int R, C; stage_rc(tid * 16 + i * 8192, R, C); const int Rb = Epi::PERM ? ((R & ~31) + perm32(R & 31)) : R;
        voffA[i] = (unsigned)(R * K + C) * 2u; voffB[i] = (unsigned)(Rb * K + C) * 2u; }
    const size_t kstep = (size_t)(BK * 2);
    const size_t hstep = (size_t)HALF * K * 2;
    const size_t tstep = 2 * hstep;
    const unsigned ldsw = (unsigned)wid * 1024u;
    const int aoff = lds_byte(wr * 64 + fr, fq * 8), boff = lds_byte(wc * 32 + fr, fq * 8);
#define PG8_SA(b, h) (((b) * 2 + (h)) * HTB)
#define PG8_SB(b, h) ((4 + (b) * 2 + (h)) * HTB)
#define PG8_STAGE(bufoff, gbase, voff) do { _Pragma("unroll") for (int _i = 0; _i < 2; ++_i) \
        __builtin_amdgcn_global_load_lds((const unsigned*)((const char*)(gbase) + (voff)[_i]), (PG8_LAS unsigned*)(lds + (bufoff) + ldsw + _i * 8192), 16, 0, 0); } while (0)
#define PG8_LDA(dst, b, h) do { _Pragma("unroll") for (int m = 0; m < 4; ++m) _Pragma("unroll") for (int k = 0; k < 2; ++k) dst[m][k] = *(const PG8_LAS bf16x8*)(lds + PG8_SA(b, h) + aoff + m * 2048 + k * 1024); } while (0)
#define PG8_LDB(dst, b, h) do { _Pragma("unroll") for (int n = 0; n < 2; ++n) _Pragma("unroll") for (int k = 0; k < 2; ++k) dst[n][k] = *(const PG8_LAS bf16x8*)(lds + PG8_SB(b, h) + boff + n * 2048 + k * 1024); } while (0)
#define PG8_MMA(ai, bj, At, Bt) do { __builtin_amdgcn_s_setprio(1); _Pragma("unroll") for (int m = 0; m < 4; ++m) _Pragma("unroll") for (int n = 0; n < 2; ++n) _Pragma("unroll") for (int k = 0; k < 2; ++k) \
        acc[ai][bj][m][n] = __builtin_amdgcn_mfma_f32_16x16x32_bf16(Bt[n][k], At[m][k], acc[ai][bj][m][n], 0, 0, 0); __builtin_amdgcn_s_setprio(0); } while (0)
#define PG8_WAIT_V(n) asm volatile("s_waitcnt vmcnt(" #n ")" ::: "memory")
#define PG8_WAIT_L(n) asm volatile("s_waitcnt lgkmcnt(" #n ")" ::: "memory")
#define PG8_BAR __builtin_amdgcn_s_barrier()
#define PG8_SCHED __builtin_amdgcn_sched_barrier(0)
    Unit cur, nxt; int ui = 0;
    if (!S.next(0, cur)) return;
    f32x4 acc[2][2][4][2];
#pragma unroll
    for (int a = 0; a < 2; ++a)
#pragma unroll
        for (int b = 0; b < 2; ++b)
#pragma unroll
            for (int m = 0; m < 4; ++m)
#pragma unroll
                for (int n = 0; n < 2; ++n) acc[a][b][m][n] = (f32x4){0.f, 0.f, 0.f, 0.f};
    bf16x8 At[4][2], B0[2][2], B1[2][2];
    const char* cA = (const char*)g.A + (size_t)cur.pm * tstep; const char* cB = (const char*)g.Bt + (size_t)cur.pn * tstep;
    S.a_ready(cur);
    if constexpr (SP2) {
        PG8_STAGE(PG8_SB(0, 0), cB, voffB); PG8_STAGE(PG8_SB(0, 1), cB + hstep, voffB); PG8_STAGE(PG8_SA(0, 0), cA, voffA); PG8_STAGE(PG8_SA(0, 1), cA + hstep, voffA);
        if (wr == 1) PG8_BAR;
        PG8_WAIT_V(2); PG8_BAR;
        PG8_STAGE(PG8_SB(1, 0), cB + kstep, voffB); PG8_STAGE(PG8_SA(1, 0), cA + kstep, voffA); PG8_STAGE(PG8_SB(1, 1), cB + hstep + kstep, voffB);
        PG8_WAIT_V(6); PG8_BAR;
    } else {
        PG8_STAGE(PG8_SB(0, 0), cB, voffB); PG8_STAGE(PG8_SA(0, 0), cA, voffA); PG8_STAGE(PG8_SB(0, 1), cB + hstep, voffB); PG8_STAGE(PG8_SA(0, 1), cA + hstep, voffA);
        if (wr == 1) PG8_BAR;
        PG8_WAIT_V(4); PG8_BAR;
        PG8_STAGE(PG8_SB(1, 0), cB + kstep, voffB); PG8_STAGE(PG8_SA(1, 0), cA + kstep, voffA); PG8_STAGE(PG8_SB(1, 1), cB + hstep + kstep, voffB);
        PG8_WAIT_V(6); PG8_BAR;
    }
    for (;;) {
        const bool has_next = S.next(ui + 1, nxt);
        const char* nA = has_next ? (const char*)g.A + (size_t)nxt.pm * tstep : cA; const char* nB = has_next ? (const char*)g.Bt + (size_t)nxt.pn * tstep : cB;
        for (int t = 0; t < nt; t += 2) {
            const bool last = (t == nt - 2);
            const char* a1 = cA + (size_t)(t + 1) * kstep;
            const char* a2 = last ? nA : cA + (size_t)(t + 2) * kstep; const char* b2 = last ? nB : cB + (size_t)(t + 2) * kstep;
            const char* a3 = a2 + kstep; const char* b3 = b2 + kstep;
            if (last && has_next) S.a_ready(nxt);
            if constexpr (SP2) {
            PG8_LDB(B0, 0, 0); PG8_LDB(B1, 0, 1); PG8_SCHED; PG8_LDA(At, 0, 0); PG8_STAGE(PG8_SA(1, 1), a1 + hstep, voffA);
            PG8_WAIT_V(8); PG8_WAIT_L(0); PG8_BAR; PG8_MMA(0, 0, At, B0); PG8_MMA(0, 1, At, B1); PG8_BAR; PG8_SCHED;
            PG8_LDA(At, 0, 1); PG8_STAGE(PG8_SB(0, 0), b2, voffB); PG8_STAGE(PG8_SB(0, 1), b2 + hstep, voffB); PG8_STAGE(PG8_SA(0, 0), a2, voffA);
            PG8_WAIT_V(8); PG8_WAIT_L(0); PG8_BAR; PG8_MMA(1, 0, At, B0); PG8_MMA(1, 1, At, B1); PG8_BAR; PG8_SCHED;
            PG8_LDB(B0, 1, 0); PG8_LDB(B1, 1, 1); PG8_SCHED; PG8_LDA(At, 1, 0); PG8_STAGE(PG8_SA(0, 1), a2 + hstep, voffA);
            PG8_WAIT_V(8); PG8_WAIT_L(0); PG8_BAR; PG8_MMA(0, 0, At, B0); PG8_MMA(0, 1, At, B1); PG8_BAR; PG8_SCHED;
            PG8_LDA(At, 1, 1); PG8_STAGE(PG8_SB(1, 0), b3, voffB); PG8_STAGE(PG8_SB(1, 1), b3 + hstep, voffB); PG8_STAGE(PG8_SA(1, 0), a3, voffA);
            PG8_WAIT_V(8); PG8_WAIT_L(0); PG8_BAR; PG8_MMA(1, 0, At, B0); PG8_MMA(1, 1, At, B1); PG8_BAR; PG8_SCHED;
            } else {
            PG8_LDB(B0, 0, 0); PG8_SCHED; PG8_LDA(At, 0, 0); PG8_STAGE(PG8_SA(1, 1), a1 + hstep, voffA);
            PG8_WAIT_L(8); PG8_BAR; PG8_WAIT_L(0); PG8_MMA(0, 0, At, B0); PG8_BAR; PG8_SCHED;
            PG8_LDB(B1, 0, 1); PG8_STAGE(PG8_SB(0, 0), b2, voffB);
            PG8_BAR; PG8_WAIT_L(0); PG8_MMA(0, 1, At, B1); PG8_BAR;
            PG8_LDA(At, 0, 1); PG8_STAGE(PG8_SA(0, 0), a2, voffA);
            PG8_BAR; PG8_WAIT_L(0); PG8_MMA(1, 0, At, B0); PG8_BAR; PG8_SCHED;
            PG8_STAGE(PG8_SB(0, 1), b2 + hstep, voffB);
            PG8_WAIT_V(6); PG8_BAR; PG8_MMA(1, 1, At, B1); PG8_BAR;
            PG8_LDB(B0, 1, 0); PG8_SCHED; PG8_LDA(At, 1, 0); PG8_STAGE(PG8_SA(0, 1), a2 + hstep, voffA);
            PG8_WAIT_L(8); PG8_BAR; PG8_WAIT_L(0); PG8_MMA(0, 0, At, B0); PG8_BAR; PG8_SCHED;
            PG8_LDB(B1, 1, 1); PG8_STAGE(PG8_SB(1, 0), b3, voffB);
            PG8_BAR; PG8_WAIT_L(0); PG8_MMA(0, 1, At, B1); PG8_BAR;
            PG8_LDA(At, 1, 1); PG8_STAGE(PG8_SA(1, 0), a3, voffA);
            PG8_BAR; PG8_WAIT_L(0); PG8_MMA(1, 0, At, B0); PG8_BAR; PG8_SCHED;
            PG8_STAGE(PG8_SB(1, 1), b3 + hstep, voffB);
            PG8_WAIT_V(6); PG8_BAR; PG8_MMA(1, 1, At, B1); PG8_BAR;
            }
        }
        if constexpr (ALIGN_EPI) { if (wr == 0) PG8_BAR; }
        if constexpr (!Epi::AFTER_DRAIN) { E(acc, cur, wr, wc, fr, fq); S.done(cur); }
        if (!has_next) break;
#pragma unroll
        for (int a = 0; a < 2; ++a)
#pragma unroll
            for (int b = 0; b < 2; ++b)
#pragma unroll
                for (int m = 0; m < 4; ++m)
#pragma unroll
                    for (int n = 0; n < 2; ++n) acc[a][b][m][n] = (f32x4){0.f, 0.f, 0.f, 0.f};
        cur = nxt; cA = nA; cB = nB; ++ui;
        if constexpr (ALIGN_EPI) { if (wr == 1) PG8_BAR; }
    }
    PG8_WAIT_V(0);
    if constexpr (!ALIGN_EPI) { if (wr == 0) PG8_BAR; }
    PG8_BAR;
    if constexpr (Epi::AFTER_DRAIN) { E.fused(acc, cur, wr, wc, fr, fq, lds, wid, lane); S.done(cur); }
#undef PG8_SA
#undef PG8_SB
#undef PG8_STAGE
#undef PG8_LDA
#undef PG8_LDB
#undef PG8_MMA
#undef PG8_WAIT_V
#undef PG8_WAIT_L
#undef PG8_BAR
#undef PG8_SCHED
}
}

constexpr int D = 2048, NB = 4, SEQ = 2048, LC = 256, TB = LC + SEQ  , TT = NB * TB  ;
constexpr int NP = 7680  , NPW = 7696  , DFF = 5632, NE = 8, NCH = 18  ;
constexpr float NORM_EPS = 1e-6f;
constexpr int NWAVES = 8, NTHR = 512;
#ifndef MK_PER_PHASE
#define MK_PER_PHASE 0
#endif
constexpr int N_PHASES = 20;
constexpr size_t MiB = 1u << 20;
constexpr size_t WS_CTL = 0, CTL_ZERO_BYTES = 64 * 1024;
constexpr size_t WS_G16 = 1 * MiB;
constexpr size_t WS_LIST = 2 * MiB;
constexpr size_t WS_TOKINFO = 3 * MiB;
constexpr size_t WS_MODP = 4 * MiB;
constexpr size_t WS_MSM = 12 * MiB;
constexpr size_t WS_WIN = 16 * MiB;
constexpr size_t WS_WOUT = 76 * MiB;
constexpr size_t WS_WF13 = 92 * MiB;
constexpr size_t WS_WF2 = 136 * MiB;
constexpr size_t WS_WE13 = 158 * MiB;
constexpr size_t WS_WE2 = 510 * MiB;
constexpr size_t WS_X = 686 * MiB;
constexpr size_t WS_H = 758 * MiB;
constexpr size_t WS_Y = 794 * MiB;
constexpr size_t WS_P = 866 * MiB;
constexpr size_t WS_RST = 1001 * MiB;
constexpr size_t WS_HST = 1037 * MiB;
constexpr size_t WS_MST = 1055 * MiB;
constexpr size_t WS_MIX = 1077 * MiB;
constexpr size_t WS_U = 866 * MiB;
constexpr size_t WS_HG = 1113 * MiB;
constexpr size_t WS_YS = 1185 * MiB;
constexpr size_t WS_END = 1329 * MiB;
static_assert(WS_U + (size_t)18432 * DFF * 2 <= WS_HG, "U overlay");
constexpr int CW_BAR = 1024, CW_CNT = 8192;
constexpr int LDS_BYTES = 163840, MISC_OFF = LDS_BYTES - 512;

#define GAS __attribute__((address_space(1)))
#define LAS __attribute__((address_space(3)))
typedef unsigned short bf16;
typedef unsigned v4u __attribute__((ext_vector_type(4)));
typedef unsigned v2u __attribute__((ext_vector_type(2)));
typedef float f32x4 __attribute__((ext_vector_type(4)));
typedef short bf16x8 __attribute__((ext_vector_type(8)));
#define LDS_WAIT() asm volatile("s_waitcnt lgkmcnt(0)" ::: "memory")
#define VM_WAIT() asm volatile("s_waitcnt vmcnt(0)" ::: "memory")
__device__ __forceinline__ unsigned f2bf(float f) { unsigned u = __builtin_bit_cast(unsigned, f); return (u + 0x7fffu + ((u >> 16) & 1u)) >> 16; }
__device__ __forceinline__ unsigned pk2(float lo, float hi) { return f2bf(lo) | (f2bf(hi) << 16); }
__device__ __forceinline__ float bf2f(unsigned b) { return __builtin_bit_cast(float, b << 16); }
__device__ __forceinline__ float bflo(unsigned w) { return __builtin_bit_cast(float, w << 16); }
__device__ __forceinline__ float bfhi(unsigned w) { return __builtin_bit_cast(float, w & 0xffff0000u); }
__device__ __forceinline__ float wave_sum(float v) {
#pragma unroll
    for (int o = 1; o < 64; o <<= 1) v += __shfl_xor(v, o);
    return v;
}
__device__ __forceinline__ float wave_max(float v) {
#pragma unroll
    for (int o = 1; o < 64; o <<= 1) v = fmaxf(v, __shfl_xor(v, o));
    return v;
}
__device__ __forceinline__ float sum16(float v) { v += __shfl_xor(v, 1); v += __shfl_xor(v, 2); v += __shfl_xor(v, 4); v += __shfl_xor(v, 8); return v; }
__device__ __forceinline__ float sigmoidf_(float x) { return 1.0f / (1.0f + __expf(-x)); }
__device__ __forceinline__ float siluf_(float x) { return x / (1.0f + __expf(-x)); }
__device__ __forceinline__ float logsigmoidf_(float x) { return fminf(x, 0.0f) - log1pf(__expf(-fabsf(x))); }
__device__ __forceinline__ bf16x8 ldsfrag(const LAS unsigned char* base, int row, int pitch, int kk, int fq) { return *(const LAS bf16x8*)(base + row * pitch + kk * 64 + fq * 16); }
#define MFMA(a, b, c) __builtin_amdgcn_mfma_f32_16x16x32_bf16((a), (b), (c), 0, 0, 0)
constexpr int PIT = 272;

#define XB_TMO      128
#define XB_XCNT(j)  (256  + 64 * (j))
#define XB_XSUB(j)  (1280 + 64 * (j))
#define XB_XGEN(j)  (2304 + 64 * (j))
#define XB_TOP      3328
#define XB_TOPGEN   3392
#define XCD_BAR_WORDS 3456
#define XB_SPIN_CAP (1u << 18)
__device__ __forceinline__ unsigned xb_ld(unsigned* p)              { return __hip_atomic_load(p, __ATOMIC_RELAXED, __HIP_MEMORY_SCOPE_AGENT); }
__device__ __forceinline__ unsigned xb_add(unsigned* p, unsigned v) { return __hip_atomic_fetch_add(p, v, __ATOMIC_RELAXED, __HIP_MEMORY_SCOPE_AGENT); }
__device__ __forceinline__ unsigned xb_xcc_id() { return (unsigned)__builtin_amdgcn_s_getreg((3 << 11) | 20) & 0xFu; }
#define XB_SPIN(cond, bar) do { unsigned _sp = 0; while (cond) { __builtin_amdgcn_s_sleep(1); \
    if ((++_sp & 255u) == 0u) { if (xb_ld(&(bar)[XB_TMO])) break; if (_sp > XB_SPIN_CAP) { atomicAdd(&(bar)[XB_TMO], 1u); break; } } } } while (0)
struct XcdBarrier { unsigned* bar; unsigned x; volatile LAS unsigned* st; };
__device__ __forceinline__ XcdBarrier xcd_barrier_post(unsigned* bar, volatile LAS unsigned* st) {
    XcdBarrier b; b.bar = bar; b.x = xb_xcc_id(); b.st = st;
    if (threadIdx.x == 0) (void)xb_add(&bar[XB_XCNT(b.x)], 1u);
    return b;
}
__device__ __forceinline__ void xcd_barrier_complete(unsigned* bar, unsigned x, unsigned& nloc, unsigned& nx) {
    const unsigned G = gridDim.x * gridDim.y * gridDim.z;
    unsigned sum, cnt, mine, sp = 0u;
    for (;;) {
        sum = 0u; cnt = 0u; mine = 0u;
#pragma unroll
        for (unsigned j = 0; j < 16; ++j) { const unsigned c = xb_ld(&bar[XB_XCNT(j)]); sum += c; cnt += (c > 0u) ? 1u : 0u; mine = (j == x) ? c : mine; }
        if (sum == G) break;
        __builtin_amdgcn_s_sleep(1);
        if ((++sp & 255u) == 0u) { if (xb_ld(&bar[XB_TMO])) break; if (sp > XB_SPIN_CAP) { atomicAdd(&bar[XB_TMO], 1u); break; } }
    }
    nloc = mine > 0u ? mine : 1u; nx = cnt > 0u ? cnt : 1u;
}
__device__ __forceinline__ void xcd_barrier(const XcdBarrier& b) {
    asm volatile("s_waitcnt vmcnt(0)" ::: "memory");
    __syncthreads();
    if (threadIdx.x == 0) {
        unsigned* bar = b.bar;
        __builtin_amdgcn_s_waitcnt(0);
        unsigned nloc = b.st[0], nx = b.st[1];
        if (nloc == 0u) { xcd_barrier_complete(bar, b.x, nloc, nx); b.st[0] = nloc; b.st[1] = nx; }
        const unsigned old = xb_add(&bar[XB_XSUB(b.x)], 1u);
        const unsigned gen = old / nloc;
        if (old + 1u == (gen + 1u) * nloc) {
            __builtin_amdgcn_fence(__ATOMIC_RELEASE, "agent");
            asm volatile("s_waitcnt vmcnt(0)" ::: "memory");
            const unsigned og = xb_add(&bar[XB_TOP], 1u);
            const unsigned tg = og / nx;
            if (og + 1u == (tg + 1u) * nx) xb_add(&bar[XB_TOPGEN], 1u);
            else XB_SPIN(xb_ld(&bar[XB_TOPGEN]) == tg, bar);
            __builtin_amdgcn_fence(__ATOMIC_ACQUIRE, "agent");
            xb_add(&bar[XB_XGEN(b.x)], 1u);
            asm volatile("s_waitcnt vmcnt(0)" ::: "memory");
        } else {
            XB_SPIN(xb_ld(&bar[XB_XGEN(b.x)]) == gen, bar);
            __builtin_amdgcn_fence(__ATOMIC_ACQUIRE, "agent");
            asm volatile("s_waitcnt vmcnt(0)" ::: "memory");
        }
    }
    __syncthreads();
}

struct Ctx {
    LAS unsigned char* lds;
    int tid, lane, wave, G, bx;
    const float *x, *c, *ctx, *c_ctx, *w_ada, *b_ada, *norm_g, *w_in, *w_out, *ret_decay, *ret_gn, *hgrn_lb, *hgrn_gn, *mlstm_conv, *mlstm_gate_b, *mlstm_gn,
                *w_ffn1, *w_ffn3, *w_ffn2, *w_router, *w_exp1, *w_exp3, *w_exp2;
    float* out; unsigned char* ws;
};
#define WSP(T, off) ((T*)(C.ws + (off)))
__device__ __forceinline__ void tr_item(const float* W, int Npitch, bf16* WT, int Kd, int k0, int n0, int drow0, LAS float* scr, int lane) {
#pragma unroll 8
    for (int i = 0; i < 32; ++i) { const int kk = 2 * i + (lane >> 5); scr[kk * 33 + (lane & 31)] = W[(size_t)(k0 + kk) * Npitch + n0 + (lane & 31)]; }
    LDS_WAIT(); asm volatile("" ::: "memory");
    const int c = lane & 7;
#pragma unroll
    for (int j = 0; j < 4; ++j) { const int n = (lane >> 3) + 8 * j; const LAS float* s = scr + (8 * c) * 33 + n;
        v4u o; o.x = pk2(s[0 * 33], s[1 * 33]); o.y = pk2(s[2 * 33], s[3 * 33]); o.z = pk2(s[4 * 33], s[5 * 33]); o.w = pk2(s[6 * 33], s[7 * 33]);
        *(v4u*)(WT + (size_t)(drow0 + n) * Kd + k0 + 8 * c) = o; }
    LDS_WAIT(); asm volatile("" ::: "memory");
}
__device__ __forceinline__ void phase_prologue(const Ctx& C) {
    LAS float* scr = (LAS float*)(C.lds + C.wave * 16384);
    int lane0 = C.lane; asm volatile("" : "+v"(lane0));
    const int gw = C.bx * NWAVES + C.wave, NGW = C.G * NWAVES, lane = lane0;
    constexpr int N_ADA = 2 * 16 * 48;
    constexpr int I_IN = 32 * 240, I_OUT = 32 * 64, I_F = 5632;
    constexpr int N_TR = 2 * I_IN + 2 * I_OUT + 27 * I_F;
    for (int it = gw; it < N_ADA + N_TR; it += NGW) {
        if (it < N_ADA) {
            const int layer = it / 768, slice = (it % 768) / 48, cb = it % 48, k0 = slice * 128, c0 = cb * 256 + 4 * lane;
#pragma unroll
            for (int j = 0; j < 10; ++j) { const int idx = lane + 64 * j, v = idx >> 7, k = idx & 127; const float s = v < 4 ? C.c[v * D + k0 + k] : C.c_ctx[k0 + k]; scr[idx] = siluf_(s); }
            LDS_WAIT(); asm volatile("" ::: "memory");
            f32x4 acc[5];
#pragma unroll
            for (int v = 0; v < 5; ++v) acc[v] = (f32x4){0.f, 0.f, 0.f, 0.f};
            const float* wp = C.w_ada + ((size_t)layer * D + k0) * 12288 + c0;
#pragma unroll 8
            for (int k = 0; k < 128; ++k) { const f32x4 w = *(const f32x4*)(wp + (size_t)k * 12288);
#pragma unroll
                for (int v = 0; v < 5; ++v) acc[v] += w * scr[v * 128 + k]; }
            float* mp = WSP(float, WS_MODP) + ((size_t)(layer * 16 + slice) * 5) * 12288 + c0;
#pragma unroll
            for (int v = 0; v < 5; ++v) *(f32x4*)(mp + (size_t)v * 12288) = acc[v];
            LDS_WAIT(); asm volatile("" ::: "memory");
            continue;
        }
        int r = it - N_ADA;
        if (r < 2 * I_IN) { const int l = r / I_IN, q = r % I_IN, kb = q / 240, nb = q % 240;
            tr_item(C.w_in + (size_t)l * D * NPW, NPW, WSP(bf16, WS_WIN) + (size_t)l * NP * D, D, 64 * kb, 32 * nb, 32 * nb, scr, lane); continue; }
        r -= 2 * I_IN;
        if (r < 2 * I_OUT) { const int l = r / I_OUT, q = r % I_OUT, kb = q / 64, nb = q % 64;
            tr_item(C.w_out + (size_t)l * D * D, D, WSP(bf16, WS_WOUT) + (size_t)l * D * D, D, 64 * kb, 32 * nb, 32 * nb, scr, lane); continue; }
        r -= 2 * I_OUT;
        const int m = r / I_F, q = r % I_F;
        const bool down = (m == 2) || (m >= 19);
        if (!down) {
            const int half = (m == 1 || (m >= 11 && m < 19)) ? 1 : 0;
            const int e = m < 3 ? -1 : (m < 11 ? m - 3 : m - 11);
            const float* src = e < 0 ? (half ? C.w_ffn3 : C.w_ffn1) : (half ? C.w_exp3 : C.w_exp1) + (size_t)e * D * DFF;
            bf16* dst = e < 0 ? WSP(bf16, WS_WF13) : WSP(bf16, WS_WE13) + (size_t)e * 2 * DFF * D;
            const int kb = q / 176, nb = q % 176, n0 = 32 * nb, drow0 = (n0 >> 7) * 256 + (n0 & 127) + 128 * half;
            tr_item(src, DFF, dst, D, 64 * kb, n0, drow0, scr, lane);
        } else {
            const int e = m == 2 ? -1 : m - 19;
            const float* src = e < 0 ? C.w_ffn2 : C.w_exp2 + (size_t)e * DFF * D;
            bf16* dst = e < 0 ? WSP(bf16, WS_WF2) : WSP(bf16, WS_WE2) + (size_t)e * D * DFF;
            const int kb = q / 64, nb = q % 64;
            tr_item(src, D, dst, DFF, 64 * kb, 32 * nb, 32 * nb, scr, lane);
        }
    }
}
__device__ __forceinline__ f32x4 modsum(const Ctx& C, int l, int v, int j, int col4) {
    f32x4 s = *(const f32x4*)(C.b_ada + (size_t)l * 12288 + j * D + col4);
    const float* mp = WSP(float, WS_MODP) + ((size_t)(l * 16) * 5 + v) * 12288 + j * D + col4;
#pragma unroll 4
    for (int sl = 0; sl < 16; ++sl) s += *(const f32x4*)(mp + (size_t)sl * 5 * 12288);
    return s;
}
__device__ __forceinline__ void expert_offsets(const Ctx& C, int (&cnt)[8], int (&off)[9]) {
    const unsigned* ctl = WSP(unsigned, WS_CTL);
    off[0] = 0;
#pragma unroll
    for (int e = 0; e < 8; ++e) { cnt[e] = (int)__hip_atomic_load(ctl + CW_CNT + 64 * e, __ATOMIC_RELAXED, __HIP_MEMORY_SCOPE_AGENT); off[e + 1] = off[e] + ((cnt[e] + 255) & ~255); }
}
template <int MODE> __device__ __forceinline__ void row_phase(const Ctx& C, int layer) {
    constexpr bool UPD = MODE != 0, NRM = MODE != 3, GATES = (MODE == 0 || MODE == 2);
    const bool ROUTER = (MODE == 1 && layer == 1), lat_only = (MODE == 3) || ROUTER, from_inputs = (MODE == 0) || (MODE == 1 && layer == 0);
    const int lu = (MODE == 2) ? 0 : layer, ju = (MODE == 1) ? 2 : 5, ku = (MODE == 1) ? 1 : 3;
    const int ln = (MODE == 2) ? 1 : layer, kn = (MODE == 1) ? 2 : 0, jsh = (MODE == 1) ? 3 : 0, jsc = (MODE == 1) ? 4 : 1;
    LAS float* GV = (LAS float*)C.lds; LAS float* AV = GV + 2048; LAS float* BV = GV + 4096; LAS float* WG = GV + 6144;
    int tid0 = C.tid; asm volatile("" : "+v"(tid0));
    const int tid = tid0, lane = tid & 63, wave = C.wave;
    float* X = WSP(float, WS_X); const float* Y = WSP(float, WS_Y); bf16* H = WSP(bf16, WS_H);
    __syncthreads();
    if (GATES) { const float* wi = C.w_in + (size_t)ln * D * NPW + NP;
        for (int idx = tid; idx < D * 16; idx += NTHR) { const int col = idx >> 4, g = idx & 15; WG[g * D + col] = wi[(size_t)col * NPW + g]; } }
    if (ROUTER) { for (int idx = tid; idx < D * 8; idx += NTHR) { const int col = idx >> 3, e = idx & 7; WG[e * D + col] = C.w_router[idx]; } }
    int cnt[8], off[9];
    if (MODE == 3) expert_offsets(C, cnt, off);
    for (int chunk = C.bx; chunk < 256; chunk += C.G) {
        const int b = chunk >> 6;
        int nrows, rbase, nctx;
        if (lat_only) { nrows = 32; rbase = b * TB + LC + (chunk & 63) * 32; nctx = 0; }
        else { nrows = 36; rbase = chunk * 36; nctx = b * TB + LC - rbase; nctx = nctx < 0 ? 0 : (nctx > 36 ? 36 : nctx); }
        for (int seg = 0; seg < 2; ++seg) {
            const int i0 = seg ? nctx : 0, i1 = seg ? nrows : nctx;
            if (i0 >= i1) continue;
            const int v = seg ? b : 4, col4 = tid * 4;
            __syncthreads();
            if (UPD) { const f32x4 g = modsum(C, lu, v, ju, col4) * *(const f32x4*)(C.norm_g + (size_t)(lu * 4 + ku) * D + col4); *(LAS f32x4*)(GV + col4) = g; }
            if (NRM) { const f32x4 sc = modsum(C, ln, v, jsc, col4), sh = modsum(C, ln, v, jsh, col4);
                *(LAS f32x4*)(AV + col4) = *(const f32x4*)(C.norm_g + (size_t)(ln * 4 + kn) * D + col4) * (sc + 1.0f); *(LAS f32x4*)(BV + col4) = sh; }
            __syncthreads();
            for (int i = i0 + wave; i < i1; i += NWAVES) {
                const int row = rbase + i, tin = row - b * TB;
                const float* xsrc = from_inputs ? (tin < LC ? C.ctx + ((size_t)b * LC + tin) * D : C.x + ((size_t)b * SEQ + (tin - LC)) * D) : X + (size_t)row * D;
                f32x4 xv[8];
#pragma unroll
                for (int j = 0; j < 8; ++j) xv[j] = *(const f32x4*)(xsrc + 4 * lane + 256 * j);
                if (UPD) {
                    f32x4 yv[8];
                    if (MODE == 3) {
                        const int tok = b * SEQ + (tin - LC);
                        const int* ti = WSP(int, WS_TOKINFO) + (size_t)tok * 8;
                        const int e0 = ti[0], p0 = ti[1], e1 = ti[2], p1 = ti[3]; const float g0 = __builtin_bit_cast(float, ti[4]), g1 = __builtin_bit_cast(float, ti[5]);
                        int o0 = 0, o1 = 0;
#pragma unroll
                        for (int e = 0; e < 8; ++e) { o0 = (e0 == e) ? off[e] : o0; o1 = (e1 == e) ? off[e] : o1; }
                        const float* y0 = WSP(float, WS_YS) + (size_t)(o0 + p0) * D; const float* y1 = WSP(float, WS_YS) + (size_t)(o1 + p1) * D;
#pragma unroll
                        for (int j = 0; j < 8; ++j) yv[j] = *(const f32x4*)(y0 + 4 * lane + 256 * j) * g0 + *(const f32x4*)(y1 + 4 * lane + 256 * j) * g1;
                    } else {
#pragma unroll
                        for (int j = 0; j < 8; ++j) yv[j] = *(const f32x4*)(Y + (size_t)row * D + 4 * lane + 256 * j);
                    }
                    float ss = 0.f;
#pragma unroll
                    for (int j = 0; j < 8; ++j) ss += (yv[j].x * yv[j].x + yv[j].y * yv[j].y) + (yv[j].z * yv[j].z + yv[j].w * yv[j].w);
                    const float rs = 1.0f / sqrtf(wave_sum(ss) * (1.0f / D) + NORM_EPS);
                    float* xdst = (MODE == 3) ? C.out + ((size_t)b * SEQ + (tin - LC)) * D : X + (size_t)row * D;
#pragma unroll
                    for (int j = 0; j < 8; ++j) { xv[j] += *(const LAS f32x4*)(GV + 4 * lane + 256 * j) * (yv[j] * rs); *(f32x4*)(xdst + 4 * lane + 256 * j) = xv[j]; }
                }
                if (NRM) {
                    float ss = 0.f;
#pragma unroll
                    for (int j = 0; j < 8; ++j) ss += (xv[j].x * xv[j].x + xv[j].y * xv[j].y) + (xv[j].z * xv[j].z + xv[j].w * xv[j].w);
                    const float rs = 1.0f / sqrtf(wave_sum(ss) * (1.0f / D) + NORM_EPS);
#pragma unroll
                    for (int j = 0; j < 8; ++j) { xv[j] = (xv[j] * rs) * *(const LAS f32x4*)(AV + 4 * lane + 256 * j) + *(const LAS f32x4*)(BV + 4 * lane + 256 * j);
                        v2u w; w.x = pk2(xv[j].x, xv[j].y); w.y = pk2(xv[j].z, xv[j].w); *(v2u*)(H + (size_t)row * D + 4 * lane + 256 * j) = w; }
                    if (GATES) {
                        float outv = 0.f;
#pragma unroll 1
                        for (int g = 0; g < 16; ++g) { float a = 0.f;
#pragma unroll
                            for (int j = 0; j < 8; ++j) { const f32x4 w = *(const LAS f32x4*)(WG + g * D + 4 * lane + 256 * j); a += (xv[j].x * w.x + xv[j].y * w.y) + (xv[j].z * w.z + xv[j].w * w.w); }
                            a = wave_sum(a); outv = (lane == g) ? a : outv; }
                        if (lane < 16) WSP(float, WS_G16)[(size_t)row * 16 + lane] = outv;
                    }
                    if (ROUTER) {
                        int e0 = 0, e1 = 0; float v0 = -3.0e38f, v1 = -3.0e38f;
#pragma unroll 1
                        for (int e = 0; e < 8; ++e) { float a = 0.f;
#pragma unroll
                            for (int j = 0; j < 8; ++j) { const f32x4 w = *(const LAS f32x4*)(WG + e * D + 4 * lane + 256 * j); a += (xv[j].x * w.x + xv[j].y * w.y) + (xv[j].z * w.z + xv[j].w * w.w); }
                            a = wave_sum(a);
                            if (a > v0) { v1 = v0; e1 = e0; v0 = a; e0 = e; } else if (a > v1) { v1 = a; e1 = e; } }
                        if (lane == 0) {
                            const float g1 = 1.0f / (1.0f + __expf(v0 - v1)), g0 = 1.0f - g1;
                            unsigned* ctl = WSP(unsigned, WS_CTL);
                            const int tok = b * SEQ + (tin - LC);
                            const int p0 = (int)__hip_atomic_fetch_add(ctl + CW_CNT + 64 * e0, 1u, __ATOMIC_RELAXED, __HIP_MEMORY_SCOPE_AGENT);
                            const int p1 = (int)__hip_atomic_fetch_add(ctl + CW_CNT + 64 * e1, 1u, __ATOMIC_RELAXED, __HIP_MEMORY_SCOPE_AGENT);
                            WSP(int, WS_LIST)[e0 * 8192 + p0] = tok; WSP(int, WS_LIST)[e1 * 8192 + p1] = tok;
                            int* ti = WSP(int, WS_TOKINFO) + (size_t)tok * 8;
                            ti[0] = e0; ti[1] = p0; ti[2] = e1; ti[3] = p1; ti[4] = __builtin_bit_cast(int, g0); ti[5] = __builtin_bit_cast(int, g1);
                        }
                    }
                }
            }
        }
    }
    __syncthreads();
}
__device__ __forceinline__ void phase_gather(const Ctx& C) {
    int cnt[8], off[9]; expert_offsets(C, cnt, off);
    int lane0 = C.lane; asm volatile("" : "+v"(lane0));
    const int gw = C.bx * NWAVES + C.wave, NGW = C.G * NWAVES, lane = lane0;
    const bf16* H = WSP(bf16, WS_H); bf16* HG = WSP(bf16, WS_HG);
    for (int slot = gw; slot < off[8]; slot += NGW) {
        int e = 0, oe = 0, ce = cnt[0];
#pragma unroll
        for (int j = 1; j < 8; ++j) if (slot >= off[j]) { e = j; oe = off[j]; ce = cnt[j]; }
        const int pos = slot - oe;
        v4u d[4];
        if (pos < ce) { const int tok = WSP(int, WS_LIST)[e * 8192 + pos]; const size_t row = (size_t)(tok >> 11) * TB + LC + (tok & 2047);
#pragma unroll
            for (int j = 0; j < 4; ++j) d[j] = *(const v4u*)(H + row * D + 8 * lane + 512 * j);
        } else {
#pragma unroll
            for (int j = 0; j < 4; ++j) d[j] = (v4u){0u, 0u, 0u, 0u};
        }
#pragma unroll
        for (int j = 0; j < 4; ++j) *(v4u*)(HG + (size_t)slot * D + 8 * lane + 512 * j) = d[j];
    }
}
#ifndef GRPMASK
#define GRPMASK 7
#endif
__device__ __forceinline__ int chain_chunk(int dir, int step) { return dir == 0 ? step : (step == 0 ? 1 : (step == 1 ? 0 : 19 - step)); }
__device__ __forceinline__ void unpack8(const v4u w, float (&f)[8]) { f[0] = bflo(w.x); f[1] = bfhi(w.x); f[2] = bflo(w.y); f[3] = bfhi(w.y); f[4] = bflo(w.z); f[5] = bfhi(w.z); f[6] = bflo(w.w); f[7] = bfhi(w.w); }
__device__ __forceinline__ void store_state_tile(bf16* ST, int e, int d0, const f32x4 s) { v2u w; w.x = pk2(s[0], s[1]); w.y = pk2(s[2], s[3]); *(v2u*)(ST + (size_t)e * 128 + d0) = w; }
__device__ __forceinline__ void rotary16(float (&x1)[16], float (&x2)[16], int g, int tl, const LAS float* inv) {
    const float pos = (float)((g < 2) ? (tl >> 6) : (tl & 63));
#pragma unroll
    for (int i = 0; i < 16; ++i) { float sn, cs; sincosf(pos * inv[16 * (g & 1) + i], &sn, &cs); const float a = x1[i], b = x2[i]; x1[i] = a * cs - b * sn; x2[i] = b * cs + a * sn; }
}
__device__ __forceinline__ void phase_state(const Ctx& C, int layer) {
    LAS unsigned char* lds = C.lds;
    LAS unsigned char* KT = lds;
    LAS unsigned char* VT = lds + 34816;
    LAS float* LB = (LAS float*)(lds + 57344);
    LAS float* QT = (LAS float*)(lds + 124928);
    LAS float* SC = (LAS float*)(lds + 126976);
    const int w = C.wave, g = w >> 1;
    const bf16* P = WSP(bf16, WS_P);
    __syncthreads();
    if (C.tid < 32) SC[768 + C.tid] = __expf(-(float)C.tid * (9.210340371976184f / 32.0f));
    for (int ch = C.bx; ch < 256; ch += C.G) {
        const int grp = ch < 128 ? 0 : (ch < 192 ? 1 : 2);
        const int xx = grp == 0 ? ch : (grp == 1 ? ch - 128 : ch - 192);
        const int b = grp == 0 ? (xx >> 5) : (xx >> 4), h = grp == 0 ? ((xx >> 3) & 3) : ((xx >> 2) & 3), dir = grp == 0 ? ((xx >> 2) & 1) : ((xx >> 1) & 1), es = grp == 0 ? (xx & 3) : (xx & 1);
        f32x4 S[5];
#pragma unroll
        for (int i = 0; i < 5; ++i) S[i] = (f32x4){0.f, 0.f, 0.f, 0.f};
        __syncthreads();
        const int tid = C.tid;
        if (grp == 1 && tid < 128) { const int chn = h * 128 + tid; SC[640 + tid] = layer == 0 ? 0.0f : sigmoidf_(C.hgrn_lb[512 + chn] - C.hgrn_lb[chn]); }
        if (grp == 2) { if (tid < 384) { const int j = tid >> 7, dd = tid & 127; SC[1024 + tid] = C.mlstm_conv[(size_t)layer * 3072 + j * 1024 + 512 + h * 128 + dd]; }
            for (int idx = tid; idx < 16 * 128; idx += NTHR) { const int er = idx >> 7, sc = idx & 127; *(LAS bf16*)(VT + (64 + er) * PIT + sc * 2) = (er == 0) ? (bf16)0x3F80 : (bf16)0; } }
        const float lg = grp == 0 ? logsigmoidf_(C.ret_decay[layer * 8 + dir * 4 + h]) : 0.0f;
        float mrun = 0.0f;
        __syncthreads();
        for (int step = 0; step < NCH; ++step) {
            int tid0 = C.tid; asm volatile("" : "+v"(tid0));
            const int tid = tid0, lane = tid & 63, fr = lane & 15, fq = lane >> 4, s = tid & 127;
            const int c = chain_chunk(dir, step);
            const size_t row = (size_t)b * TB + 128 * c + s;
            const bf16* prow = P + row * NP;
            float decay_s = 1.0f;
            if ((GRPMASK & 1) && grp == 0) {
                float k1[16], k2[16];
                { const bf16* kp = prow + 512 + h * 128 + 16 * g; float t8[8];
                  unpack8(*(const v4u*)kp, t8);
#pragma unroll
                  for (int i = 0; i < 8; ++i) k1[i] = t8[i];
                  unpack8(*(const v4u*)(kp + 8), t8);
#pragma unroll
                  for (int i = 0; i < 8; ++i) k1[8 + i] = t8[i];
                  unpack8(*(const v4u*)(kp + 64), t8);
#pragma unroll
                  for (int i = 0; i < 8; ++i) k2[i] = t8[i];
                  unpack8(*(const v4u*)(kp + 72), t8);
#pragma unroll
                  for (int i = 0; i < 8; ++i) k2[8 + i] = t8[i]; }
                if (c >= 2) rotary16(k1, k2, g, 128 * (c - 2) + s, SC + 768);
                const int tau = dir ? 127 - s : s;
                const float wk = __expf((float)(127 - tau) * lg) * 0.08838834764831845f;
#pragma unroll
                for (int i = 0; i < 16; ++i) { *(LAS bf16*)(KT + (16 * g + i) * PIT + s * 2) = (bf16)f2bf(k1[i] * wk); *(LAS bf16*)(KT + (64 + 16 * g + i) * PIT + s * 2) = (bf16)f2bf(k2[i] * wk); }
                const bf16* vp = prow + 1024 + h * 256 + 64 * es + 16 * g;
                const v4u v0 = *(const v4u*)vp, v1 = *(const v4u*)(vp + 8);
                const unsigned vw[8] = {v0.x, v0.y, v0.z, v0.w, v1.x, v1.y, v1.z, v1.w};
#pragma unroll
                for (int i = 0; i < 8; ++i) { *(LAS bf16*)(VT + (16 * g + 2 * i) * PIT + s * 2) = (bf16)(vw[i] & 0xffffu); *(LAS bf16*)(VT + (16 * g + 2 * i + 1) * PIT + s * 2) = (bf16)(vw[i] >> 16); }
                decay_s = __expf(128.0f * lg);
            } else if ((GRPMASK & 2) && grp == 1) {
                const bf16* fp = prow + 3584 + dir * 512 + h * 128 + 32 * g;
#pragma unroll
                for (int q = 0; q < 4; ++q) { float t8[8]; unpack8(*(const v4u*)(fp + 8 * q), t8); float lf8[8];
#pragma unroll
                    for (int i = 0; i < 8; ++i) { const float x = t8[i], lbv = SC[640 + 32 * g + 8 * q + i], ex = __expf(-fabsf(x)), r = 1.0f / (1.0f + ex);
                        const float sg = x >= 0.f ? r : ex * r, sgm = x >= 0.f ? ex * r : r;
                        lf8[i] = logf(lbv + (1.0f - lbv) * sg); *(LAS bf16*)(KT + (32 * g + 8 * q + i) * PIT + s * 2) = (bf16)f2bf((1.0f - lbv) * sgm); }
                    *(LAS f32x4*)(LB + s * 132 + 32 * g + 8 * q) = (f32x4){lf8[0], lf8[1], lf8[2], lf8[3]};
                    *(LAS f32x4*)(LB + s * 132 + 32 * g + 8 * q + 4) = (f32x4){lf8[4], lf8[5], lf8[6], lf8[7]}; }
                __syncthreads();
                { const int dq = tid & 127, q4 = tid >> 7; float run = 0.f;
                  for (int i = 0; i < 32; ++i) { const int ss = dir ? (32 * q4 + 31 - i) : (32 * q4 + i); run += LB[ss * 132 + dq]; LB[ss * 132 + dq] = run; }
                  QT[q4 * 128 + dq] = run; }
                __syncthreads();
                { const int q4s = s >> 5;
#pragma unroll 4
                  for (int i = 0; i < 32; ++i) { const int dd = 32 * g + i; const float t0 = QT[dd], t1 = QT[128 + dd], t2 = QT[256 + dd], t3 = QT[384 + dd];
                      float offv;
                      if (dir == 0) offv = (q4s > 0 ? t0 : 0.f) + (q4s > 1 ? t1 : 0.f) + (q4s > 2 ? t2 : 0.f);
                      else offv = (q4s < 3 ? t3 : 0.f) + (q4s < 2 ? t2 : 0.f) + (q4s < 1 ? t1 : 0.f);
                      const float bb = LB[s * 132 + dd] + offv, bl = (t0 + t1) + (t2 + t3);
                      LAS bf16* kp2 = (LAS bf16*)(KT + dd * PIT + s * 2); *kp2 = (bf16)f2bf(bf2f(*kp2) * __expf(bl - bb)); } }
                const bf16* vp = prow + 4608 + h * 128 + 64 * es + 16 * g;
                const v4u v0 = *(const v4u*)vp, v1 = *(const v4u*)(vp + 8);
                const unsigned vw[8] = {v0.x, v0.y, v0.z, v0.w, v1.x, v1.y, v1.z, v1.w};
#pragma unroll
                for (int i = 0; i < 8; ++i) { *(LAS bf16*)(VT + (16 * g + 2 * i) * PIT + s * 2) = (bf16)(vw[i] & 0xffffu); *(LAS bf16*)(VT + (16 * g + 2 * i + 1) * PIT + s * 2) = (bf16)(vw[i] >> 16); }
            } else if ((GRPMASK & 4) && grp == 2) {
                if (tid < 128) { const float* gp = WSP(float, WS_G16) + row * 16; const float* gb = C.mlstm_gate_b + layer * 16;
                    SC[s] = logsigmoidf_(gp[8 + 4 * dir + h] + gb[8 + 4 * dir + h]); SC[128 + s] = gp[4 * dir + h] + gb[4 * dir + h]; }
                __syncthreads();
                if (tid < 128) { float run = 0.f; if (dir == 0) { for (int u = 0; u <= s; ++u) run += SC[u]; } else { for (int u = 127; u >= s; --u) run += SC[u]; } SC[256 + s] = run; }
                __syncthreads();
                const float bl = dir == 0 ? SC[256 + 127] : SC[256];
                if (tid < 128) { const float be = bl - SC[256 + s] + SC[128 + s]; SC[384 + s] = be; const float mx = wave_max(be); if (lane == 0) SC[512 + w] = mx; }
                __syncthreads();
                const float mloc = fmaxf(SC[512], SC[513]), mnew = fmaxf(bl + mrun, mloc);
                decay_s = __expf(bl + mrun - mnew);
                const float ws = __expf(SC[384 + s] - mnew) * 0.08838834764831845f;
                const int tall = 128 * c + s, seg0 = c < 2 ? 0 : LC, seg1 = c < 2 ? LC : TB;
                const bool hp = tall - 1 >= seg0, hn = tall + 1 < seg1;
                const bf16* kp = prow + 6144 + h * 128 + 32 * g;
#pragma unroll
                for (int q = 0; q < 4; ++q) { float a8[8], t8[8];
                    unpack8(*(const v4u*)(kp + 8 * q), t8);
#pragma unroll
                    for (int i = 0; i < 8; ++i) a8[i] = t8[i] * SC[1024 + 128 + 32 * g + 8 * q + i];
                    if (hp) { unpack8(*(const v4u*)(kp - NP + 8 * q), t8);
#pragma unroll
                        for (int i = 0; i < 8; ++i) a8[i] += t8[i] * SC[1024 + 32 * g + 8 * q + i]; }
                    if (hn) { unpack8(*(const v4u*)(kp + NP + 8 * q), t8);
#pragma unroll
                        for (int i = 0; i < 8; ++i) a8[i] += t8[i] * SC[1024 + 256 + 32 * g + 8 * q + i]; }
#pragma unroll
                    for (int i = 0; i < 8; ++i) *(LAS bf16*)(KT + (32 * g + 8 * q + i) * PIT + s * 2) = (bf16)f2bf(siluf_(a8[i]) * ws); }
                const bf16* vp = prow + 6656 + h * 128 + 64 * es + 16 * g;
                const v4u v0 = *(const v4u*)vp, v1 = *(const v4u*)(vp + 8);
                const unsigned vw[8] = {v0.x, v0.y, v0.z, v0.w, v1.x, v1.y, v1.z, v1.w};
#pragma unroll
                for (int i = 0; i < 8; ++i) { *(LAS bf16*)(VT + (16 * g + 2 * i) * PIT + s * 2) = (bf16)(vw[i] & 0xffffu); *(LAS bf16*)(VT + (16 * g + 2 * i + 1) * PIT + s * 2) = (bf16)(vw[i] >> 16); }
                if (es == 0 && tid == 0) WSP(float, WS_MSM)[((b * 4 + h) * 2 + dir) * NCH + c] = mrun;
                mrun = mnew;
            }
            __syncthreads();
            const size_t sidx = (size_t)(((b * 4 + h) * 2 + dir) * NCH + c);
            const int d0 = 16 * w + 4 * fq;
            if (grp == 0) { bf16* ST = WSP(bf16, WS_RST) + sidx * (256 * 128);
#pragma unroll
                for (int ei = 0; ei < 4; ++ei) store_state_tile(ST, 64 * es + 16 * ei + fr, d0, S[ei]);
#pragma unroll
                for (int ei = 0; ei < 4; ++ei) S[ei] *= decay_s;
            } else if (grp == 1) { bf16* ST = WSP(bf16, WS_HST) + sidx * (128 * 128);
#pragma unroll
                for (int ei = 0; ei < 4; ++ei) store_state_tile(ST, 64 * es + 16 * ei + fr, d0, S[ei]);
                f32x4 dv;
#pragma unroll
                for (int r = 0; r < 4; ++r) { const int dd = d0 + r; dv[r] = __expf((QT[dd] + QT[128 + dd]) + (QT[256 + dd] + QT[384 + dd])); }
#pragma unroll
                for (int ei = 0; ei < 4; ++ei) S[ei] *= dv;
            } else { bf16* ST = WSP(bf16, WS_MST) + sidx * (144 * 128);
#pragma unroll
                for (int ei = 0; ei < 4; ++ei) store_state_tile(ST, 64 * es + 16 * ei + fr, d0, S[ei]);
                if (es == 0) store_state_tile(ST, 128 + fr, d0, S[4]);
#pragma unroll
                for (int ei = 0; ei < 5; ++ei) S[ei] *= decay_s;
            }
#pragma unroll
            for (int kk4 = 0; kk4 < 4; ++kk4) { const bf16x8 a = ldsfrag(KT, 16 * w + fr, PIT, kk4, fq);
#pragma unroll
                for (int ei = 0; ei < 4; ++ei) S[ei] = MFMA(a, ldsfrag(VT, 16 * ei + fr, PIT, kk4, fq), S[ei]);
                if (grp == 2) S[4] = MFMA(a, ldsfrag(VT, 64 + fr, PIT, kk4, fq), S[4]); }
            __syncthreads();
        }
    }
}
__device__ __forceinline__ void stage_vt128(LAS unsigned char* VT, const bf16* vp  , int g, int s) {
#pragma unroll
    for (int q = 0; q < 4; ++q) { const v4u v = *(const v4u*)(vp + 8 * q); const unsigned vw[4] = {v.x, v.y, v.z, v.w};
#pragma unroll
        for (int i = 0; i < 4; ++i) { *(LAS bf16*)(VT + (32 * g + 8 * q + 2 * i) * PIT + s * 2) = (bf16)(vw[i] & 0xffffu); *(LAS bf16*)(VT + (32 * g + 8 * q + 2 * i + 1) * PIT + s * 2) = (bf16)(vw[i] >> 16); } }
}
__device__ __forceinline__ void stage_rot16(LAS unsigned char* dst, const bf16* src, bool rot, int g, int tl, const LAS float* inv, float scale, int s) {
    float x1[16], x2[16], t8[8];
    unpack8(*(const v4u*)src, t8);
#pragma unroll
    for (int i = 0; i < 8; ++i) x1[i] = t8[i];
    unpack8(*(const v4u*)(src + 8), t8);
#pragma unroll
    for (int i = 0; i < 8; ++i) x1[8 + i] = t8[i];
    unpack8(*(const v4u*)(src + 64), t8);
#pragma unroll
    for (int i = 0; i < 8; ++i) x2[i] = t8[i];
    unpack8(*(const v4u*)(src + 72), t8);
#pragma unroll
    for (int i = 0; i < 8; ++i) x2[8 + i] = t8[i];
    if (rot) rotary16(x1, x2, g, tl, inv);
    v4u o;
    o.x = pk2(x1[0] * scale, x1[1] * scale); o.y = pk2(x1[2] * scale, x1[3] * scale); o.z = pk2(x1[4] * scale, x1[5] * scale); o.w = pk2(x1[6] * scale, x1[7] * scale); *(LAS v4u*)(dst + s * PIT + (16 * g) * 2) = o;
    o.x = pk2(x1[8] * scale, x1[9] * scale); o.y = pk2(x1[10] * scale, x1[11] * scale); o.z = pk2(x1[12] * scale, x1[13] * scale); o.w = pk2(x1[14] * scale, x1[15] * scale); *(LAS v4u*)(dst + s * PIT + (16 * g + 8) * 2) = o;
    o.x = pk2(x2[0] * scale, x2[1] * scale); o.y = pk2(x2[2] * scale, x2[3] * scale); o.z = pk2(x2[4] * scale, x2[5] * scale); o.w = pk2(x2[6] * scale, x2[7] * scale); *(LAS v4u*)(dst + s * PIT + (64 + 16 * g) * 2) = o;
    o.x = pk2(x2[8] * scale, x2[9] * scale); o.y = pk2(x2[10] * scale, x2[11] * scale); o.z = pk2(x2[12] * scale, x2[13] * scale); o.w = pk2(x2[14] * scale, x2[15] * scale); *(LAS v4u*)(dst + s * PIT + (64 + 16 * g + 8) * 2) = o;
    asm volatile("" ::: "memory");
}
__device__ __forceinline__ void phase_out(const Ctx& C, int layer) {
    LAS unsigned char* lds = C.lds;
    const int w = C.wave, g = w >> 1;
    const bf16* P = WSP(bf16, WS_P); bf16* MIX = WSP(bf16, WS_MIX);
    LAS float* SC = (LAS float*)(lds + 139264);
    __syncthreads();
    if (C.tid < 32) SC[2048 + C.tid] = __expf(-(float)C.tid * (9.210340371976184f / 32.0f));
    __syncthreads();
    constexpr int NU = 3 * NB * 4 * NCH;
    for (int u = C.bx; u < NU; u += C.G) {
        int tid0 = C.tid; asm volatile("" : "+v"(tid0));
        const int tid = tid0, lane = tid & 63, fr = lane & 15, fq = lane >> 4, s = tid & 127;
        const int grp = u / 288, uu = u % 288, b = uu / 72, h = (uu % 72) / NCH, c = uu % NCH;
        const size_t row0 = (size_t)b * TB + 128 * c;
        const bf16* prow = P + (row0 + s) * NP;
        const size_t sidx_f = (size_t)(((b * 4 + h) * 2 + 0) * NCH + c), sidx_b = (size_t)(((b * 4 + h) * 2 + 1) * NCH + c);
#ifndef GRPMASK
#define GRPMASK 7
#endif
        if ((GRPMASK & 1) && grp == 0) {
            LAS unsigned char* QL = lds; LAS unsigned char* KL = lds + 34816; LAS unsigned char* AL = lds + 69632; LAS unsigned char* VT = lds + 104448;
            const float lgf = logsigmoidf_(C.ret_decay[layer * 8 + h]), lgb = logsigmoidf_(C.ret_decay[layer * 8 + 4 + h]);
            stage_rot16(QL, prow + h * 128 + 16 * g, c >= 2, g, 128 * (c - 2) + s, SC + 2048, 1.0f, s);
            stage_rot16(KL, prow + 512 + h * 128 + 16 * g, c >= 2, g, 128 * (c - 2) + s, SC + 2048, 0.08838834764831845f, s);
            __syncthreads();
            bf16x8 qf[4];
#pragma unroll
            for (int kk = 0; kk < 4; ++kk) qf[kk] = ldsfrag(QL, 16 * w + fr, PIT, kk, fq);
            {   f32x4 sa[8];
#pragma unroll
                for (int j = 0; j < 8; ++j) sa[j] = (f32x4){0.f, 0.f, 0.f, 0.f};
#pragma unroll
                for (int kk = 0; kk < 4; ++kk)
#pragma unroll
                    for (int j = 0; j < 8; ++j) sa[j] = MFMA(qf[kk], ldsfrag(KL, 16 * j + fr, PIT, kk, fq), sa[j]);
#pragma unroll
                for (int j = 0; j < 8; ++j)
#pragma unroll
                    for (int r = 0; r < 4; ++r) { const int t = 16 * w + 4 * fq + r, ss = 16 * j + fr; const float dl = (float)(t - ss);
                        const float dm = (ss <= t ? __expf(dl * lgf) : 0.f) + (ss >= t ? __expf(-dl * lgb) : 0.f);
                        *(LAS bf16*)(AL + t * PIT + ss * 2) = (bf16)f2bf(sa[j][r] * dm); }
            }
            f32x4 o[2][8];
            float dqf[4], dqb[4];
#pragma unroll
            for (int r = 0; r < 4; ++r) { const int t = 16 * w + 4 * fq + r; dqf[r] = __expf((float)(t + 1) * lgf); dqb[r] = __expf((float)(128 - t) * lgb); }
#pragma unroll
            for (int half = 0; half < 2; ++half) {
                if (half == 1) __syncthreads();
                stage_vt128(VT, prow + 1024 + h * 256 + 128 * half + 32 * g, g, s);
                __syncthreads();
#pragma unroll
                for (int ei = 0; ei < 8; ++ei) o[half][ei] = (f32x4){0.f, 0.f, 0.f, 0.f};
#pragma unroll
                for (int kk = 0; kk < 4; ++kk) { const bf16x8 a = ldsfrag(AL, 16 * w + fr, PIT, kk, fq);
#pragma unroll
                    for (int ei = 0; ei < 8; ++ei) o[half][ei] = MFMA(a, ldsfrag(VT, 16 * ei + fr, PIT, kk, fq), o[half][ei]); }
#pragma unroll 1
                for (int dir = 0; dir < 2; ++dir) {
                    const bf16* ST = WSP(bf16, WS_RST) + (dir ? sidx_b : sidx_f) * (256 * 128) + (size_t)(128 * half) * 128 + (size_t)fr * 128 + 8 * fq;
                    f32x4 ia[8];
#pragma unroll
                    for (int ei = 0; ei < 8; ++ei) ia[ei] = (f32x4){0.f, 0.f, 0.f, 0.f};
#pragma unroll
                    for (int kk = 0; kk < 4; ++kk) {
#pragma unroll
                        for (int ei = 0; ei < 8; ++ei) { const bf16x8 bb = *(const bf16x8*)(ST + ei * 2048 + 32 * kk); ia[ei] = MFMA(qf[kk], bb, ia[ei]); }
                        __builtin_amdgcn_sched_barrier(0); }
#pragma unroll
                    for (int ei = 0; ei < 8; ++ei)
#pragma unroll
                        for (int r = 0; r < 4; ++r) o[half][ei][r] += (dir ? dqb[r] : dqf[r]) * ia[ei][r];
                }
            }
            float rs[4];
#pragma unroll
            for (int r = 0; r < 4; ++r) { float q = 0.f;
#pragma unroll
                for (int half = 0; half < 2; ++half)
#pragma unroll
                    for (int ei = 0; ei < 8; ++ei) q += o[half][ei][r] * o[half][ei][r];
                rs[r] = 1.0f / sqrtf(sum16(q) * (1.0f / 256.0f) + NORM_EPS); }
#pragma unroll
            for (int half = 0; half < 2; ++half)
#pragma unroll
                for (int ei = 0; ei < 8; ++ei) { const int e = 128 * half + 16 * ei + fr; const float gn = C.ret_gn[layer * 1024 + h * 256 + e];
#pragma unroll
                    for (int r = 0; r < 4; ++r) { const size_t row = row0 + 16 * w + 4 * fq + r; const float gt = bf2f(P[row * NP + 2048 + h * 256 + e]);
                        MIX[row * D + h * 256 + e] = (bf16)f2bf(o[half][ei][r] * rs[r] * gn * siluf_(gt)); } }
            __syncthreads();
        } else if ((GRPMASK & 2) && grp == 1) {
            LAS float* BB = (LAS float*)lds;
            LAS unsigned char* QL = lds + 67584; LAS unsigned char* KL = lds + 102400;
            LAS float* QT = (LAS float*)(lds + 137216);
            LAS unsigned char* AL = lds; LAS unsigned char* VT = lds + 34816;
            if (tid < 128) { const int chn = h * 128 + tid; SC[tid] = layer == 0 ? 0.0f : sigmoidf_(C.hgrn_lb[512 + chn] - C.hgrn_lb[chn]); }
            __syncthreads();
            f32x4 oa[8], aa[8];
#pragma unroll
            for (int j = 0; j < 8; ++j) { oa[j] = (f32x4){0.f, 0.f, 0.f, 0.f}; aa[j] = (f32x4){0.f, 0.f, 0.f, 0.f}; }
#pragma unroll 1
            for (int dir = 0; dir < 2; ++dir) {
                {   const bf16* fp = prow + 3584 + dir * 512 + h * 128 + 32 * g; const bf16* qp = prow + 3072 + h * 128 + 32 * g;
#pragma unroll 1
                    for (int q = 0; q < 4; ++q) { float t8[8], lf8[8], k8[8]; unpack8(*(const v4u*)(fp + 8 * q), t8);
#pragma unroll
                        for (int i = 0; i < 8; ++i) { const float x = t8[i], lbv = SC[32 * g + 8 * q + i], ex = __expf(-fabsf(x)), rr = 1.0f / (1.0f + ex);
                            const float sg = x >= 0.f ? rr : ex * rr, sgm = x >= 0.f ? ex * rr : rr;
                            lf8[i] = logf(lbv + (1.0f - lbv) * sg); k8[i] = (1.0f - lbv) * sgm; }
                        *(LAS f32x4*)(BB + s * 132 + 32 * g + 8 * q) = (f32x4){lf8[0], lf8[1], lf8[2], lf8[3]};
                        *(LAS f32x4*)(BB + s * 132 + 32 * g + 8 * q + 4) = (f32x4){lf8[4], lf8[5], lf8[6], lf8[7]};
                        v4u o4; o4.x = pk2(k8[0], k8[1]); o4.y = pk2(k8[2], k8[3]); o4.z = pk2(k8[4], k8[5]); o4.w = pk2(k8[6], k8[7]);
                        *(LAS v4u*)(KL + s * PIT + (32 * g + 8 * q) * 2) = o4;
                        if (dir == 0) { unpack8(*(const v4u*)(qp + 8 * q), t8);
                            o4.x = pk2(siluf_(t8[0]), siluf_(t8[1])); o4.y = pk2(siluf_(t8[2]), siluf_(t8[3])); o4.z = pk2(siluf_(t8[4]), siluf_(t8[5])); o4.w = pk2(siluf_(t8[6]), siluf_(t8[7]));
                            *(LAS v4u*)(QL + s * PIT + (32 * g + 8 * q) * 2) = o4; } }
                }
                __syncthreads();
                { const int dq = tid & 127, q4 = tid >> 7; float run = 0.f;
                  for (int i = 0; i < 32; ++i) { const int ss = dir ? (32 * q4 + 31 - i) : (32 * q4 + i); run += BB[ss * 132 + dq]; BB[ss * 132 + dq] = run; }
                  QT[q4 * 128 + dq] = run; }
                __syncthreads();
                { const int q4s = s >> 5;
#pragma unroll 2
                  for (int q = 0; q < 8; ++q) { f32x4 v = *(LAS f32x4*)(BB + s * 132 + 32 * g + 4 * q);
#pragma unroll
                      for (int i = 0; i < 4; ++i) { const int dd = 32 * g + 4 * q + i; const float t0 = QT[dd], t1 = QT[128 + dd], t2 = QT[256 + dd], t3 = QT[384 + dd];
                          float offv;
                          if (dir == 0) offv = (q4s > 0 ? t0 : 0.f) + (q4s > 1 ? t1 : 0.f) + (q4s > 2 ? t2 : 0.f);
                          else offv = (q4s < 3 ? t3 : 0.f) + (q4s < 2 ? t2 : 0.f) + (q4s < 1 ? t1 : 0.f);
                          v[i] += offv; }
                      *(LAS f32x4*)(BB + s * 132 + 32 * g + 4 * q) = v; } }
                __syncthreads();
                {   const int i = w, tr = dir == 0 ? 16 * i : 16 * i + 15;
                    const bf16* ST = WSP(bf16, WS_HST) + (dir ? sidx_b : sidx_f) * (128 * 128);
                    f32x4 td = (f32x4){0.f, 0.f, 0.f, 0.f};
#pragma unroll 1
                    for (int kk = 0; kk < 4; ++kk) {
                        const int dof = 32 * kk + 8 * fq;
                        const f32x4 bt0 = *(LAS f32x4*)(BB + (16 * i + fr) * 132 + dof), bt1 = *(LAS f32x4*)(BB + (16 * i + fr) * 132 + dof + 4);
                        const f32x4 rf0 = *(LAS f32x4*)(BB + tr * 132 + dof), rf1 = *(LAS f32x4*)(BB + tr * 132 + dof + 4);
                        float q8[8]; unpack8(*(const LAS v4u*)(QL + (16 * i + fr) * PIT + dof * 2), q8);
                        const float bt[8] = {bt0[0], bt0[1], bt0[2], bt0[3], bt1[0], bt1[1], bt1[2], bt1[3]}, rf[8] = {rf0[0], rf0[1], rf0[2], rf0[3], rf1[0], rf1[1], rf1[2], rf1[3]};
                        v4u qh, qe;
                        qh.x = pk2(q8[0] * __expf(bt[0] - rf[0]), q8[1] * __expf(bt[1] - rf[1])); qh.y = pk2(q8[2] * __expf(bt[2] - rf[2]), q8[3] * __expf(bt[3] - rf[3]));
                        qh.z = pk2(q8[4] * __expf(bt[4] - rf[4]), q8[5] * __expf(bt[5] - rf[5])); qh.w = pk2(q8[6] * __expf(bt[6] - rf[6]), q8[7] * __expf(bt[7] - rf[7]));
                        qe.x = pk2(q8[0] * __expf(bt[0]), q8[1] * __expf(bt[1])); qe.y = pk2(q8[2] * __expf(bt[2]), q8[3] * __expf(bt[3]));
                        qe.z = pk2(q8[4] * __expf(bt[4]), q8[5] * __expf(bt[5])); qe.w = pk2(q8[6] * __expf(bt[6]), q8[7] * __expf(bt[7]));
                        const bf16x8 qhf = __builtin_bit_cast(bf16x8, qh), qef = __builtin_bit_cast(bf16x8, qe);
#pragma unroll
                        for (int ei = 0; ei < 8; ++ei) { const bf16x8 bb = *(const bf16x8*)(ST + (size_t)(16 * ei + fr) * 128 + dof); oa[ei] = MFMA(qef, bb, oa[ei]); }
#pragma unroll
                        for (int j = 0; j < 8; ++j) {
                            if (dir == 0 ? (j <= i) : (j >= i)) {
                                const f32x4 bs0 = *(LAS f32x4*)(BB + (16 * j + fr) * 132 + dof), bs1 = *(LAS f32x4*)(BB + (16 * j + fr) * 132 + dof + 4);
                                float k8[8]; unpack8(*(const LAS v4u*)(KL + (16 * j + fr) * PIT + dof * 2), k8);
                                const float bs[8] = {bs0[0], bs0[1], bs0[2], bs0[3], bs1[0], bs1[1], bs1[2], bs1[3]};
                                v4u kh;
                                kh.x = pk2(k8[0] * __expf(fminf(rf[0] - bs[0], 60.f)), k8[1] * __expf(fminf(rf[1] - bs[1], 60.f))); kh.y = pk2(k8[2] * __expf(fminf(rf[2] - bs[2], 60.f)), k8[3] * __expf(fminf(rf[3] - bs[3], 60.f)));
                                kh.z = pk2(k8[4] * __expf(fminf(rf[4] - bs[4], 60.f)), k8[5] * __expf(fminf(rf[5] - bs[5], 60.f))); kh.w = pk2(k8[6] * __expf(fminf(rf[6] - bs[6], 60.f)), k8[7] * __expf(fminf(rf[7] - bs[7], 60.f)));
                                if (j == i) td = MFMA(qhf, __builtin_bit_cast(bf16x8, kh), td); else aa[j] = MFMA(qhf, __builtin_bit_cast(bf16x8, kh), aa[j]);
                            }
                        }
                    }
#pragma unroll
                    for (int r = 0; r < 4; ++r) { const int tl = 4 * fq + r; const bool keep = dir == 0 ? (fr <= tl) : (fr >= tl); td[r] = keep ? td[r] : 0.f; }
#pragma unroll
                    for (int j = 0; j < 8; ++j) if (j == i) aa[j] += td;
                }
                __syncthreads();
            }
#pragma unroll
            for (int j = 0; j < 8; ++j)
#pragma unroll
                for (int r = 0; r < 4; ++r) *(LAS bf16*)(AL + (16 * w + 4 * fq + r) * PIT + (16 * j + fr) * 2) = (bf16)f2bf(aa[j][r]);
            stage_vt128(VT, prow + 4608 + h * 128 + 32 * g, g, s);
            __syncthreads();
#pragma unroll
            for (int kk = 0; kk < 4; ++kk) { const bf16x8 a = ldsfrag(AL, 16 * w + fr, PIT, kk, fq);
#pragma unroll
                for (int ei = 0; ei < 8; ++ei) oa[ei] = MFMA(a, ldsfrag(VT, 16 * ei + fr, PIT, kk, fq), oa[ei]); }
            float rs[4];
#pragma unroll
            for (int r = 0; r < 4; ++r) { float q = 0.f;
#pragma unroll
                for (int ei = 0; ei < 8; ++ei) q += oa[ei][r] * oa[ei][r];
                rs[r] = 1.0f / sqrtf(sum16(q) * (1.0f / 128.0f) + NORM_EPS); }
#pragma unroll
            for (int ei = 0; ei < 8; ++ei) { const int e = 16 * ei + fr; const float gn = C.hgrn_gn[layer * 512 + h * 128 + e];
#pragma unroll
                for (int r = 0; r < 4; ++r) { const size_t row = row0 + 16 * w + 4 * fq + r; const float gt = bf2f(P[row * NP + 5120 + h * 128 + e]);
                    MIX[row * D + 1024 + h * 128 + e] = (bf16)f2bf(oa[ei][r] * rs[r] * gn * siluf_(gt)); } }
            __syncthreads();
        } else if ((GRPMASK & 4) && grp == 2) {
            LAS unsigned char* QL = lds; LAS unsigned char* KL = lds + 34816; LAS unsigned char* AL = lds + 69632; LAS unsigned char* VT = lds + 104448;
            if (tid < 256) { const int dir = tid >> 7; const float* gp = WSP(float, WS_G16) + (row0 + s) * 16; const float* gb = C.mlstm_gate_b + layer * 16;
                SC[1024 * dir + s] = logsigmoidf_(gp[8 + 4 * dir + h] + gb[8 + 4 * dir + h]); SC[1024 * dir + 128 + s] = gp[4 * dir + h] + gb[4 * dir + h]; }
            for (int idx = tid; idx < 768; idx += NTHR) { const int j = idx >> 8, qk = (idx >> 7) & 1, dd = idx & 127; SC[2304 + idx] = C.mlstm_conv[(size_t)layer * 3072 + j * 1024 + qk * 512 + h * 128 + dd]; }
            __syncthreads();
            if (tid < 256) { const int dir = tid >> 7; LAS float* Sd = SC + 1024 * dir; float run = 0.f;
                if (dir == 0) { for (int uq = 0; uq <= s; ++uq) run += Sd[uq]; } else { for (int uq = 127; uq >= s; --uq) run += Sd[uq]; }
                Sd[256 + s] = run; Sd[384 + s] = Sd[128 + s] - run; }
            __syncthreads();
            if (tid < 256) { const int dir = tid >> 7; LAS float* Sd = SC + 1024 * dir; float pm = -3.0e38f;
                if (dir == 0) { for (int uq = 0; uq <= s; ++uq) pm = fmaxf(pm, Sd[384 + uq]); } else { for (int uq = 127; uq >= s; --uq) pm = fmaxf(pm, Sd[384 + uq]); }
                const float m = WSP(float, WS_MSM)[(dir ? sidx_b : sidx_f)], bb = Sd[256 + s], mt = bb + fmaxf(pm, m);
                Sd[512 + s] = bb - mt; Sd[640 + s] = __expf(bb + m - mt); Sd[768 + s] = __expf(-mt); }
            {
                const int tall = 128 * c + s, seg0 = c < 2 ? 0 : LC, seg1 = c < 2 ? LC : TB;
                const bool hp = tall - 1 >= seg0, hn = tall + 1 < seg1;
#pragma unroll
                for (int qk = 0; qk < 2; ++qk) { const bf16* xp = prow + 5632 + qk * 512 + h * 128 + 32 * g; const LAS float* cw = SC + 2304 + qk * 128 + 32 * g;
#pragma unroll
                    for (int q = 0; q < 4; ++q) { float a8[8], t8[8];
                        unpack8(*(const v4u*)(xp + 8 * q), t8);
#pragma unroll
                        for (int i = 0; i < 8; ++i) a8[i] = t8[i] * cw[256 + 8 * q + i];
                        if (hp) { unpack8(*(const v4u*)(xp - NP + 8 * q), t8);
#pragma unroll
                            for (int i = 0; i < 8; ++i) a8[i] += t8[i] * cw[8 * q + i]; }
                        if (hn) { unpack8(*(const v4u*)(xp + NP + 8 * q), t8);
#pragma unroll
                            for (int i = 0; i < 8; ++i) a8[i] += t8[i] * cw[512 + 8 * q + i]; }
                        const float sc = qk ? 0.08838834764831845f : 1.0f;
                        v4u o4; o4.x = pk2(siluf_(a8[0]) * sc, siluf_(a8[1]) * sc); o4.y = pk2(siluf_(a8[2]) * sc, siluf_(a8[3]) * sc); o4.z = pk2(siluf_(a8[4]) * sc, siluf_(a8[5]) * sc); o4.w = pk2(siluf_(a8[6]) * sc, siluf_(a8[7]) * sc);
                        *(LAS v4u*)((qk ? KL : QL) + s * PIT + (32 * g + 8 * q) * 2) = o4; } }
            }
            stage_vt128(VT, prow + 6656 + h * 128 + 32 * g, g, s);
            __syncthreads();
            bf16x8 qf[4];
#pragma unroll
            for (int kk = 0; kk < 4; ++kk) qf[kk] = ldsfrag(QL, 16 * w + fr, PIT, kk, fq);
            f32x4 sa[8], hs[8];
#pragma unroll
            for (int j = 0; j < 8; ++j) { sa[j] = (f32x4){0.f, 0.f, 0.f, 0.f}; hs[j] = (f32x4){0.f, 0.f, 0.f, 0.f}; }
#pragma unroll
            for (int kk = 0; kk < 4; ++kk)
#pragma unroll
                for (int j = 0; j < 8; ++j) sa[j] = MFMA(qf[kk], ldsfrag(KL, 16 * j + fr, PIT, kk, fq), sa[j]);
#pragma unroll 1
            for (int dir = 0; dir < 2; ++dir) {
                const LAS float* Sd = SC + 1024 * dir;
                float den[4] = {0.f, 0.f, 0.f, 0.f};
#pragma unroll
                for (int j = 0; j < 8; ++j) { const int ss = 16 * j + fr; const float be = Sd[384 + ss];
#pragma unroll
                    for (int r = 0; r < 4; ++r) { const int t = 16 * w + 4 * fq + r; const bool valid = dir == 0 ? (ss <= t) : (ss >= t);
                        const float wgt = valid ? __expf(fminf(Sd[512 + t] + be, 0.f)) : 0.f, a = sa[j][r] * wgt; den[r] += a;
                        *(LAS bf16*)(AL + t * PIT + ss * 2) = (bf16)f2bf(a); } }
#pragma unroll
                for (int r = 0; r < 4; ++r) den[r] = sum16(den[r]);
                f32x4 ia[9];
#pragma unroll
                for (int j = 0; j < 9; ++j) ia[j] = (f32x4){0.f, 0.f, 0.f, 0.f};
                const bf16* ST = WSP(bf16, WS_MST) + (dir ? sidx_b : sidx_f) * (144 * 128) + (size_t)fr * 128 + 8 * fq;
                LDS_WAIT();
#pragma unroll
                for (int kk = 0; kk < 4; ++kk) {
#pragma unroll
                    for (int ei = 0; ei < 9; ++ei) { const bf16x8 bb = *(const bf16x8*)(ST + ei * 2048 + 32 * kk); ia[ei] = MFMA(qf[kk], bb, ia[ei]); }
                    __builtin_amdgcn_sched_barrier(0); }
                float inv[4];
#pragma unroll
                for (int r = 0; r < 4; ++r) { const int t = 16 * w + 4 * fq + r; const float wi = Sd[640 + t];
                    const float qn = __shfl(ia[8][r], lane & 48);
                    const float dt = den[r] + wi * qn; inv[r] = 1.0f / fmaxf(fabsf(dt), Sd[768 + t]);
#pragma unroll
                    for (int ei = 0; ei < 8; ++ei) ia[ei][r] *= wi; }
#pragma unroll
                for (int kk = 0; kk < 4; ++kk) { const bf16x8 a = ldsfrag(AL, 16 * w + fr, PIT, kk, fq);
#pragma unroll
                    for (int ei = 0; ei < 8; ++ei) ia[ei] = MFMA(a, ldsfrag(VT, 16 * ei + fr, PIT, kk, fq), ia[ei]);
                    __builtin_amdgcn_sched_barrier(0); }
#pragma unroll
                for (int r = 0; r < 4; ++r)
#pragma unroll
                    for (int ei = 0; ei < 8; ++ei) hs[ei][r] += ia[ei][r] * inv[r];
                LDS_WAIT();
            }
            float mean[4], rs[4];
#pragma unroll
            for (int r = 0; r < 4; ++r) { float q = 0.f;
#pragma unroll
                for (int ei = 0; ei < 8; ++ei) q += hs[ei][r];
                mean[r] = sum16(q) * (1.0f / 128.0f); float q2 = 0.f;
#pragma unroll
                for (int ei = 0; ei < 8; ++ei) { const float dlt = hs[ei][r] - mean[r]; q2 += dlt * dlt; }
                rs[r] = 1.0f / sqrtf(sum16(q2) * (1.0f / 128.0f) + NORM_EPS); }
#pragma unroll
            for (int ei = 0; ei < 8; ++ei) { const int e = 16 * ei + fr; const float gn = C.mlstm_gn[layer * 512 + h * 128 + e];
#pragma unroll
                for (int r = 0; r < 4; ++r) { const size_t row = row0 + 16 * w + 4 * fq + r; const float gt = bf2f(P[row * NP + 7168 + h * 128 + e]);
                    MIX[row * D + 1536 + h * 128 + e] = (bf16)f2bf((hs[ei][r] - mean[r]) * rs[r] * gn * sigmoidf_(gt)); } }
            __syncthreads();
        }
    }
}
struct Args { const float* in[23]; float* out; unsigned char* ws; int ph_lo, ph_hi; };
__device__ __forceinline__ void moe_tables(const Ctx& C, LAS int* tab) {
    __syncthreads();
    if (C.tid == 0) { int cnt[8], off[9]; expert_offsets(C, cnt, off);
#pragma unroll
        for (int e = 0; e < 8; ++e) { tab[e] = (off[e + 1] - off[e]) >> 8; tab[8 + e] = off[e] >> 8; tab[16 + e] = off[e] >> 8; }
        tab[24] = off[8] >> 8; }
    __syncthreads();
}
typedef const __attribute__((address_space(4))) Args* KArgs;
__device__ __forceinline__ Ctx make_ctx(unsigned char* lds_raw) {
    KArgs ka = (KArgs)__builtin_amdgcn_kernarg_segment_ptr(); asm volatile("" : "+s"(ka));
    Ctx C;
    C.lds = (LAS unsigned char*)lds_raw;
    C.tid = threadIdx.x; C.lane = C.tid & 63; C.wave = __builtin_amdgcn_readfirstlane(C.tid >> 6); C.G = gridDim.x; C.bx = blockIdx.x;
    C.x = ka->in[0]; C.c = ka->in[1]; C.ctx = ka->in[2]; C.c_ctx = ka->in[3]; C.w_ada = ka->in[4]; C.b_ada = ka->in[5]; C.norm_g = ka->in[6]; C.w_in = ka->in[7]; C.w_out = ka->in[8];
    C.ret_decay = ka->in[9]; C.ret_gn = ka->in[10]; C.hgrn_lb = ka->in[11]; C.hgrn_gn = ka->in[12]; C.mlstm_conv = ka->in[13]; C.mlstm_gate_b = ka->in[14]; C.mlstm_gn = ka->in[15];
    C.w_ffn1 = ka->in[16]; C.w_ffn3 = ka->in[17]; C.w_ffn2 = ka->in[18]; C.w_router = ka->in[19]; C.w_exp1 = ka->in[20]; C.w_exp3 = ka->in[21]; C.w_exp2 = ka->in[22];
    C.out = ka->out; C.ws = ka->ws;
    return C;
}
#ifndef PHMASK
#define PHMASK 0xFFFFF
#endif
#define IN(k) (lo <= (k) && (k) < hi)
#define EN(n) ((PHMASK >> (n)) & 1)
#define SEAM(k) do { if (!MK_PER_PHASE && IN(k) && IN((k) + 1)) xcd_barrier(bar); } while (0)
#define MKCTX() const Ctx C = make_ctx(lds_raw)
template <int layer> __device__ __forceinline__ void layer_phases(unsigned char* lds_raw, LAS int* TAB, const XcdBarrier& bar, const int lo, const int hi) {
    using namespace pg8;
        const int base = 2 + 9 * layer;
        if (EN(2) && IN(base + 0)) { MKCTX();
            Gemm g{WSP(bf16, WS_H), WSP(bf16, WS_WIN) + (size_t)layer * NP * D, TT, NP, D}; TileOrder S; S.init_static(TT, NP, C.G, C.bx);
            EpiBf16 E{WSP(bf16, WS_P), NP};
            gemm_phase<EpiBf16, TileOrder, true, true>(C.lds, g, S, E);
            SEAM(base + 0);
        }
        if (EN(3) && IN(base + 1)) { MKCTX(); phase_state(C, layer); SEAM(base + 1); }
        if (EN(4) && IN(base + 2)) { MKCTX(); phase_out(C, layer); SEAM(base + 2); }
        if (EN(5) && IN(base + 3)) { MKCTX();
            Gemm g{WSP(bf16, WS_MIX), WSP(bf16, WS_WOUT) + (size_t)layer * D * D, TT, D, D}; TileOrder S;
            if (layer == 0) S.init_static(TT, D, C.G, C.bx); else S.init_latent(C.G, C.bx);
            EpiF32 E{WSP(float, WS_Y), D};
            gemm_phase<EpiF32, TileOrder, true, true>(C.lds, g, S, E);
            SEAM(base + 3);
        }
        if (EN(6) && IN(base + 4)) { MKCTX(); row_phase<1>(C, layer); SEAM(base + 4); }
        if (EN(7) && IN(base + 5)) { MKCTX(); if (layer == 1) phase_gather(C); SEAM(base + 5); }
        if (EN(8) && IN(base + 6)) { MKCTX();
            TileOrder S; Gemm g;
            if (layer == 0) { g = Gemm{WSP(bf16, WS_H), WSP(bf16, WS_WF13), TT, 2 * DFF, D}; S.init_static(TT, 2 * DFF, C.G, C.bx); }
            else { moe_tables(C, TAB); g = Gemm{WSP(bf16, WS_HG), WSP(bf16, WS_WE13), 0, 2 * DFF, D}; S.init_moe(TAB, 44, C.G, C.bx); }
            EpiSwiGLU E{WSP(bf16, WS_U), DFF};
            gemm_phase<EpiSwiGLU, TileOrder, true, true>(C.lds, g, S, E);
            SEAM(base + 6);
        }
        if (EN(9) && IN(base + 7)) { MKCTX();
            TileOrder S; Gemm g; EpiF32 E;
            if (layer == 0) { g = Gemm{WSP(bf16, WS_U), WSP(bf16, WS_WF2), TT, D, DFF}; S.init_static(TT, D, C.G, C.bx); E = EpiF32{WSP(float, WS_Y), D}; }
            else { moe_tables(C, TAB); g = Gemm{WSP(bf16, WS_U), WSP(bf16, WS_WE2), 0, D, DFF}; S.init_moe(TAB, 8, C.G, C.bx); E = EpiF32{WSP(float, WS_YS), D}; }
            gemm_phase<EpiF32, TileOrder, true, true>(C.lds, g, S, E);
            SEAM(base + 7);
        }
        if (EN(10) && IN(base + 8)) { MKCTX(); if (layer == 0) row_phase<2>(C, 0); else row_phase<3>(C, 1); SEAM(base + 8); }
}
__global__ void __launch_bounds__(NTHR, 2) fwd_kernel(Args args) {
    extern __shared__ __attribute__((aligned(16))) unsigned char lds_raw[];
    volatile LAS unsigned* MISC = (volatile LAS unsigned*)((LAS unsigned char*)lds_raw + MISC_OFF);
    LAS int* TAB = (LAS int*)((LAS unsigned char*)lds_raw + MISC_OFF + 64);
    if (threadIdx.x < 128) MISC[threadIdx.x] = 0u;
    __syncthreads();
    XcdBarrier bar; bar.bar = (unsigned*)(args.ws + WS_CTL) + CW_BAR; bar.x = 0; bar.st = nullptr;
    if (!MK_PER_PHASE) bar = xcd_barrier_post((unsigned*)(args.ws + WS_CTL) + CW_BAR, MISC);
    const int lo = args.ph_lo, hi = args.ph_hi;
    using namespace pg8;
    if (EN(0) && IN(0)) { MKCTX(); phase_prologue(C); SEAM(0); }
    if (EN(1) && IN(1)) { MKCTX(); row_phase<0>(C, 0); SEAM(1); }
    layer_phases<0>(lds_raw, TAB, bar, lo, hi);
    layer_phases<1>(lds_raw, TAB, bar, lo, hi);
#undef IN
#undef SEAM
}

extern "C" void kernel_launch(void* const* d_in, const int* in_sizes, int n_in, void* d_out, int out_size, void* d_ws, size_t ws_size, hipStream_t stream) {
    static int grid = 0;
    if (grid == 0) {
        if (n_in != 23 || out_size != NB * SEQ * D || ws_size < WS_END) { fprintf(stderr, "kernel_launch: unexpected shapes (n_in %d, out %d, ws %zu < %zu); nothing launched\n", n_in, out_size, ws_size, (size_t)WS_END); grid = -1; return; }
        int dev = 0, cus = 0, per_cu = 0;
        if (hipGetDevice(&dev) != hipSuccess || hipDeviceGetAttribute(&cus, hipDeviceAttributeMultiprocessorCount, dev) != hipSuccess) { grid = -1; return; }
        if (hipFuncSetAttribute((const void*)fwd_kernel, hipFuncAttributeMaxDynamicSharedMemorySize, LDS_BYTES) != hipSuccess) { fprintf(stderr, "kernel_launch: hipFuncSetAttribute failed\n"); grid = -1; return; }
        if (hipOccupancyMaxActiveBlocksPerMultiprocessor(&per_cu, (const void*)fwd_kernel, NTHR, LDS_BYTES) != hipSuccess || per_cu < 1) fprintf(stderr, "kernel_launch: occupancy query reports %d\n", per_cu);
        (void)hipGetLastError();
        grid = cus;
    }
    if (grid < 0) return;
    (void)hipMemsetAsync((char*)d_ws + WS_CTL, 0, CTL_ZERO_BYTES, stream);
    Args a{};
    for (int i = 0; i < 23; ++i) a.in[i] = (const float*)d_in[i];
    a.out = (float*)d_out; a.ws = (unsigned char*)d_ws;
#if MK_PER_PHASE
    for (int p = 0; p < N_PHASES; ++p) { if (p == 7) continue; a.ph_lo = p; a.ph_hi = p + 1; hipLaunchKernelGGL(fwd_kernel, dim3(grid), dim3(NTHR), LDS_BYTES, stream, a); }
#else
    a.ph_lo = 0; a.ph_hi = N_PHASES; hipLaunchKernelGGL(fwd_kernel, dim3(grid), dim3(NTHR), LDS_BYTES, stream, a);
#endif
}
```

```cpp
#include <hip/hip_runtime.h>
#include <cstdio>
#include <cstdint>
namespace pg8 {
#define PG8_LAS __attribute__((address_space(3)))
typedef unsigned short bf16_t;
typedef short bf16x8 __attribute__((ext_vector_type(8)));
typedef float f32x4 __attribute__((ext_vector_type(4)));
typedef unsigned u32x4 __attribute__((ext_vector_type(4)));
constexpr int BM = 256, BK = 64, HALF = 128, HTB = HALF * BK * 2  , STAGE_BYTES = 8 * HTB, NXCD = 8, WGM = 8;

__host__ __device__ __forceinline__ int lds_byte(int r, int c) { const int st = (r >> 4) * 2 + (c >> 5), rr = r & 15, cc = c & 31, ob = rr * 64 + cc * 2; return st * 1024 + (ob ^ (((ob >> 9) & 1) << 5)); }
__host__ __device__ __forceinline__ void stage_rc(int b, int& R, int& C) { const int st = b / 1024, sb = b % 1024, swz = sb ^ (((sb >> 9) & 1) << 5); R = (st >> 1) * 16 + swz / 64; C = (st & 1) * 32 + (swz % 64) / 2; }
__host__ __device__ __forceinline__ int perm32(int rho) { const int n = rho >> 4, i = rho & 15; return 8 * (i >> 2) + 4 * n + (i & 3); }


struct Unit { int pm, pn, po; };
struct Gemm { const bf16_t* A; const bf16_t* Bt; int M, N, K; };
__device__ __forceinline__ unsigned cvt_pk_bf16(float lo, float hi) { unsigned r; asm volatile("v_cvt_pk_bf16_f32 %0, %1, %2" : "=v"(r) : "v"(lo), "v"(hi)); return r; }

struct TileOrder {
    int mode, nM, nN, nwg, G, c, NT; const PG8_LAS int* tab;
    __device__ __forceinline__ void init_static(int M, int N, int G_, int c_) { mode = 0; nM = M / BM; nN = N / BM; nwg = nM * nN; G = G_; c = c_; NT = 0; tab = nullptr; }
    __device__ __forceinline__ void init_latent(int G_, int c_) { mode = 1; nM = 32; nN = 8; nwg = 256; G = G_; c = c_; NT = 0; tab = nullptr; }
    __device__ __forceinline__ void init_moe(const PG8_LAS int* tab_, int NT_, int G_, int c_) { mode = 2; tab = tab_; NT = NT_; nM = 0; nN = NT_; nwg = tab_[24] * NT_; G = G_; c = c_; }
    __device__ __forceinline__ bool next(int i, Unit& u) const {
        const long L = (long)i * G + c; if (L >= nwg) return false;
        if (mode == 0) {
            int wgid = (int)L; { const int q = nwg / NXCD, r = nwg % NXCD, xcd = wgid % NXCD, off = wgid / NXCD; wgid = (xcd < r ? xcd * (q + 1) : r * (q + 1) + (xcd - r) * q) + off; }
            const int nig = WGM * nN, gid = wgid / nig, fm = gid * WGM, gsz = (nM - fm) < WGM ? (nM - fm) : WGM;
            u.pm = fm + ((wgid % nig) % gsz); u.pn = (wgid % nig) / gsz; u.po = u.pn; return true;
        } else if (mode == 1) {
            const int l = (int)L, idx = l & 31; u.pn = l >> 5; u.po = u.pn; u.pm = 9 * (idx >> 3) + 1 + (idx & 7); return true;
        } else {
            const int l = (int)L; int e = 0;
#pragma unroll
            for (int j = 1; j < 8; ++j) if (l >= tab[16 + j] * NT) e = j;
            const int idx = l - tab[16 + e] * NT, te = tab[e], pml = idx % te, pnl = idx / te;
            u.pm = tab[8 + e] + pml; u.pn = e * NT + pnl; u.po = pnl; return true;
        }
    }
    __device__ __forceinline__ void a_ready(const Unit&) const {}
    __device__ __forceinline__ void done(const Unit&) const {}
};

struct EpiF32 {
    static constexpr bool PERM = false, AFTER_DRAIN = false;
    float* C; int ldc;
    __device__ __forceinline__ void operator()(const f32x4 (&acc)[2][2][4][2], const Unit& u, int wr, int wc, int fr, int fq) const {
        const int row0 = u.pm * BM + wr * 64 + fr, col0 = u.po * BM + wc * 32 + 4 * fq;
#pragma unroll
        for (int ai = 0; ai < 2; ++ai)
#pragma unroll
            for (int m = 0; m < 4; ++m) { float* rowp = C + (size_t)(row0 + ai * HALF + m * 16) * ldc + col0;
#pragma unroll
                for (int bj = 0; bj < 2; ++bj)
#pragma unroll
                    for (int n = 0; n < 2; ++n) *(f32x4*)(rowp + bj * HALF + n * 16) = acc[ai][bj][m][n]; }
    }
};
struct EpiBf16 {
    static constexpr bool PERM = true, AFTER_DRAIN = false;
    bf16_t* O; int ldc;
    __device__ __forceinline__ void operator()(const f32x4 (&acc)[2][2][4][2], const Unit& u, int wr, int wc, int fr, int fq) const {
        const int row0 = u.pm * BM + wr * 64 + fr, col0 = u.po * BM + wc * 32 + 8 * fq;
#pragma unroll
        for (int ai = 0; ai < 2; ++ai)
#pragma unroll
            for (int m = 0; m < 4; ++m) { bf16_t* rowp = O + (size_t)(row0 + ai * HALF + m * 16) * ldc + col0;
#pragma unroll
                for (int bj = 0; bj < 2; ++bj) { const f32x4 v0 = acc[ai][bj][m][0], v1 = acc[ai][bj][m][1];
                    u32x4 w; w.x = cvt_pk_bf16(v0[0], v0[1]); w.y = cvt_pk_bf16(v0[2], v0[3]); w.z = cvt_pk_bf16(v1[0], v1[1]); w.w = cvt_pk_bf16(v1[2], v1[3]);
                    *(u32x4*)(rowp + bj * HALF) = w; } }
    }
};
struct EpiSwiGLU {
    static constexpr bool PERM = true, AFTER_DRAIN = false;
    bf16_t* O; int ldc;
    __device__ __forceinline__ void operator()(const f32x4 (&acc)[2][2][4][2], const Unit& u, int wr, int wc, int fr, int fq) const {
        const int row0 = u.pm * BM + wr * 64 + fr, col0 = u.po * HALF + wc * 32 + 8 * fq;
#pragma unroll
        for (int ai = 0; ai < 2; ++ai)
#pragma unroll
            for (int m = 0; m < 4; ++m) { bf16_t* rowp = O + (size_t)(row0 + ai * HALF + m * 16) * ldc + col0;
                float o[8];
#pragma unroll
                for (int n = 0; n < 2; ++n)
#pragma unroll
                    for (int j = 0; j < 4; ++j) { const float a = acc[ai][0][m][n][j], b = acc[ai][1][m][n][j]; o[4 * n + j] = a * __builtin_amdgcn_rcpf(1.0f + __expf(-a)) * b; }
                u32x4 w; w.x = cvt_pk_bf16(o[0], o[1]); w.y = cvt_pk_bf16(o[2], o[3]); w.z = cvt_pk_bf16(o[4], o[5]); w.w = cvt_pk_bf16(o[6], o[7]);
                *(u32x4*)rowp = w; }
    }
};
template <class Epi, class Sched, bool ALIGN_EPI = false, bool SP2 = false>
__device__ __forceinline__ void gemm_phase(PG8_LAS unsigned char* lds, const Gemm g, const Sched& S, const Epi& E) {
    int tid0 = threadIdx.x; asm volatile("" : "+v"(tid0));
    const int tid = tid0, wid = __builtin_amdgcn_readfirstlane(tid >> 6), lane = tid & 63, wr = wid >> 2, wc = wid & 3, fr = lane & 15, fq = lane >> 4;
    const int K = g.K, nt = K / BK;
    unsigned voffA[2], voffB[2];
#pragma unroll
    for (int i = 0; i < 2; ++i) { int R, C; stage_rc(tid * 16 + i * 8192, R, C); const int Rb = Epi::PERM ? ((R & ~31) + perm32(R & 31)) : R;
        voffA[i] = (unsigned)(R * K + C) * 2u; voffB[i] = (unsigned)(Rb * K + C) * 2u; }
    const size_t kstep = (size_t)(BK * 2);
    const size_t hstep = (size_t)HALF * K * 2;
    const size_t tstep = 2 * hstep;
    const unsigned ldsw = (unsigned)wid * 1024u;
    const int aoff = lds_byte(wr * 64 + fr, fq * 8), boff = lds_byte(wc * 32 + fr, fq * 8);
#define PG8_SA(b, h) (((b) * 2 + (h)) * HTB)
#define PG8_SB(b, h) ((4 + (b) * 2 + (h)) * HTB)
#define PG8_STAGE(bufoff, gbase, voff) do { _Pragma("unroll") for (int _i = 0; _i < 2; ++_i) \
        __builtin_amdgcn_global_load_lds((const unsigned*)((const char*)(gbase) + (voff)[_i]), (PG8_LAS unsigned*)(lds + (bufoff) + ldsw + _i * 8192), 16, 0, 0); } while (0)
#define PG8_LDA(dst, b, h) do { _Pragma("unroll") for (int m = 0; m < 4; ++m) _Pragma("unroll") for (int k = 0; k < 2; ++k) dst[m][k] = *(const PG8_LAS bf16x8*)(lds + PG8_SA(b, h) + aoff + m * 2048 + k * 1024); } while (0)
#define PG8_LDB(dst, b, h) do { _Pragma("unroll") for (int n = 0; n < 2; ++n) _Pragma("unroll") for (int k = 0; k < 2; ++k) dst[n][k] = *(const PG8_LAS bf16x8*)(lds + PG8_SB(b, h) + boff + n * 2048 + k * 1024); } while (0)
#define PG8_MMA(ai, bj, At, Bt) do { __builtin_amdgcn_s_setprio(1); _Pragma("unroll") for (int m = 0; m < 4; ++m) _Pragma("unroll") for (int n = 0; n < 2; ++n) _Pragma("unroll") for (int k = 0; k < 2; ++k) \
        acc[ai][bj][m][n] = __builtin_amdgcn_mfma_f32_16x16x32_bf16(Bt[n][k], At[m][k], acc[ai][bj][m][n], 0, 0, 0); __builtin_amdgcn_s_setprio(0); } while (0)
#define PG8_WAIT_V(n) asm volatile("s_waitcnt vmcnt(" #n ")" ::: "memory")
#define PG8_WAIT_L(n) asm volatile("s_waitcnt lgkmcnt(" #n ")" ::: "memory")
#define PG8_BAR __builtin_amdgcn_s_barrier()
#define PG8_SCHED __builtin_amdgcn_sched_barrier(0)
    Unit cur, nxt; int ui = 0;
    if (!S.next(0, cur)) return;
    f32x4 acc[2][2][4][2];
#pragma unroll
    for (int a = 0; a < 2; ++a)
#pragma unroll
        for (int b = 0; b < 2; ++b)
#pragma unroll
            for (int m = 0; m < 4; ++m)
#pragma unroll
                for (int n = 0; n < 2; ++n) acc[a][b][m][n] = (f32x4){0.f, 0.f, 0.f, 0.f};
    bf16x8 At[4][2], B0[2][2], B1[2][2];
    const char* cA = (const char*)g.A + (size_t)cur.pm * tstep; const char* cB = (const char*)g.Bt + (size_t)cur.pn * tstep;
    S.a_ready(cur);
    if constexpr (SP2) {
        PG8_STAGE(PG8_SB(0, 0), cB, voffB); PG8_STAGE(PG8_SB(0, 1), cB + hstep, voffB); PG8_STAGE(PG8_SA(0, 0), cA, voffA); PG8_STAGE(PG8_SA(0, 1), cA + hstep, voffA);
        if (wr == 1) PG8_BAR;
        PG8_WAIT_V(2); PG8_BAR;
        PG8_STAGE(PG8_SB(1, 0), cB + kstep, voffB); PG8_STAGE(PG8_SA(1, 0), cA + kstep, voffA); PG8_STAGE(PG8_SB(1, 1), cB + hstep + kstep, voffB);
        PG8_WAIT_V(6); PG8_BAR;
    } else {
        PG8_STAGE(PG8_SB(0, 0), cB, voffB); PG8_STAGE(PG8_SA(0, 0), cA, voffA); PG8_STAGE(PG8_SB(0, 1), cB + hstep, voffB); PG8_STAGE(PG8_SA(0, 1), cA + hstep, voffA);
        if (wr == 1) PG8_BAR;
        PG8_WAIT_V(4); PG8_BAR;
        PG8_STAGE(PG8_SB(1, 0), cB + kstep, voffB); PG8_STAGE(PG8_SA(1, 0), cA + kstep, voffA); PG8_STAGE(PG8_SB(1, 1), cB + hstep + kstep, voffB);
        PG8_WAIT_V(6); PG8_BAR;
    }
    for (;;) {
        const bool has_next = S.next(ui + 1, nxt);
        const char* nA = has_next ? (const char*)g.A + (size_t)nxt.pm * tstep : cA; const char* nB = has_next ? (const char*)g.Bt + (size_t)nxt.pn * tstep : cB;
        for (int t = 0; t < nt; t += 2) {
            const bool last = (t == nt - 2);
            const char* a1 = cA + (size_t)(t + 1) * kstep;
            const char* a2 = last ? nA : cA + (size_t)(t + 2) * kstep; const char* b2 = last ? nB : cB + (size_t)(t + 2) * kstep;
            const char* a3 = a2 + kstep; const char* b3 = b2 + kstep;
            if (last && has_next) S.a_ready(nxt);
            if constexpr (SP2) {
            PG8_LDB(B0, 0, 0); PG8_LDB(B1, 0, 1); PG8_SCHED; PG8_LDA(At, 0, 0); PG8_STAGE(PG8_SA(1, 1), a1 + hstep, voffA);
            PG8_WAIT_V(8); PG8_WAIT_L(0); PG8_BAR; PG8_MMA(0, 0, At, B0); PG8_MMA(0, 1, At, B1); PG8_BAR; PG8_SCHED;
            PG8_LDA(At, 0, 1); PG8_STAGE(PG8_SB(0, 0), b2, voffB); PG8_STAGE(PG8_SB(0, 1), b2 + hstep, voffB); PG8_STAGE(PG8_SA(0, 0), a2, voffA);
            PG8_WAIT_V(8); PG8_WAIT_L(0); PG8_BAR; PG8_MMA(1, 0, At, B0); PG8_MMA(1, 1, At, B1); PG8_BAR; PG8_SCHED;
            PG8_LDB(B0, 1, 0); PG8_LDB(B1, 1, 1); PG8_SCHED; PG8_LDA(At, 1, 0); PG8_STAGE(PG8_SA(0, 1), a2 + hstep, voffA);
            PG8_WAIT_V(8); PG8_WAIT_L(0); PG8_BAR; PG8_MMA(0, 0, At, B0); PG8_MMA(0, 1, At, B1); PG8_BAR; PG8_SCHED;
            PG8_LDA(At, 1, 1); PG8_STAGE(PG8_SB(1, 0), b3, voffB); PG8_STAGE(PG8_SB(1, 1), b3 + hstep, voffB); PG8_STAGE(PG8_SA(1, 0), a3, voffA);
            PG8_WAIT_V(8); PG8_WAIT_L(0); PG8_BAR; PG8_MMA(1, 0, At, B0); PG8_MMA(1, 1, At, B1); PG8_BAR; PG8_SCHED;
            } else {
            PG8_LDB(B0, 0, 0); PG8_SCHED; PG8_LDA(At, 0, 0); PG8_STAGE(PG8_SA(1, 1), a1 + hstep, voffA);
            PG8_WAIT_L(8); PG8_BAR; PG8_WAIT_L(0); PG8_MMA(0, 0, At, B0); PG8_BAR; PG8_SCHED;
            PG8_LDB(B1, 0, 1); PG8_STAGE(PG8_SB(0, 0), b2, voffB);
            PG8_BAR; PG8_WAIT_L(0); PG8_MMA(0, 1, At, B1); PG8_BAR;
            PG8_LDA(At, 0, 1); PG8_STAGE(PG8_SA(0, 0), a2, voffA);
            PG8_BAR; PG8_WAIT_L(0); PG8_MMA(1, 0, At, B0); PG8_BAR; PG8_SCHED;
            PG8_STAGE(PG8_SB(0, 1), b2 + hstep, voffB);
            PG8_WAIT_V(6); PG8_BAR; PG8_MMA(1, 1, At, B1); PG8_BAR;
            PG8_LDB(B0, 1, 0); PG8_SCHED; PG8_LDA(At, 1, 0); PG8_STAGE(PG8_SA(0, 1), a2 + hstep, voffA);
            PG8_WAIT_L(8); PG8_BAR; PG8_WAIT_L(0); PG8_MMA(0, 0, At, B0); PG8_BAR; PG8_SCHED;
            PG8_LDB(B1, 1, 1); PG8_STAGE(PG8_SB(1, 0), b3, voffB);
            PG8_BAR; PG8_WAIT_L(0); PG8_MMA(0, 1, At, B1); PG8_BAR;
            PG8_LDA(At, 1, 1); PG8_STAGE(PG8_SA(1, 0), a3, voffA);
            PG8_BAR; PG8_WAIT_L(0); PG8_MMA(1, 0, At, B0); PG8_BAR; PG8_SCHED;
            PG8_STAGE(PG8_SB(1, 1), b3 + hstep, voffB);
            PG8_WAIT_V(6); PG8_BAR; PG8_MMA(1, 1, At, B1); PG8_BAR;
            }
        }
        if constexpr (ALIGN_EPI) { if (wr == 0) PG8_BAR; }
        if constexpr (!Epi::AFTER_DRAIN) { E(acc, cur, wr, wc, fr, fq); S.done(cur); }
        if (!has_next) break;
#pragma unroll
        for (int a = 0; a < 2; ++a)
#pragma unroll
            for (int b = 0; b < 2; ++b)
#pragma unroll
                for (int m = 0; m < 4; ++m)
#pragma unroll
                    for (int n = 0; n < 2; ++n) acc[a][b][m][n] = (f32x4){0.f, 0.f, 0.f, 0.f};
        cur = nxt; cA = nA; cB = nB; ++ui;
        if constexpr (ALIGN_EPI) { if (wr == 1) PG8_BAR; }
    }
    PG8_WAIT_V(0);
    if constexpr (!ALIGN_EPI) { if (wr == 0) PG8_BAR; }
    PG8_BAR;
    if constexpr (Epi::AFTER_DRAIN) { E.fused(acc, cur, wr, wc, fr, fq, lds, wid, lane); S.done(cur); }
#undef PG8_SA
#undef PG8_SB
#undef PG8_STAGE
#undef PG8_LDA
#undef PG8_LDB
#undef PG8_MMA
#undef PG8_WAIT_V
#undef PG8_WAIT_L
#undef PG8_BAR
#undef PG8_SCHED
}
}

constexpr int D = 2048, NB = 4, SEQ = 2048, LC = 256, TB = LC + SEQ  , TT = NB * TB  ;
constexpr int NP = 7680  , NPW = 7696  , DFF = 5632, NE = 8, NCH = 18  ;
constexpr float NORM_EPS = 1e-6f;
constexpr int NWAVES = 8, NTHR = 512;
#ifndef MK_PER_PHASE
#define MK_PER_PHASE 0
#endif
constexpr int N_PHASES = 20;
constexpr size_t MiB = 1u << 20;
constexpr size_t WS_CTL = 0, CTL_ZERO_BYTES = 64 * 1024;
constexpr size_t WS_G16 = 1 * MiB;
constexpr size_t WS_LIST = 2 * MiB;
constexpr size_t WS_TOKINFO = 3 * MiB;
constexpr size_t WS_MODP = 4 * MiB;
constexpr size_t WS_MSM = 12 * MiB;
constexpr size_t WS_WIN = 16 * MiB;
constexpr size_t WS_WOUT = 76 * MiB;
constexpr size_t WS_WF13 = 92 * MiB;
constexpr size_t WS_WF2 = 136 * MiB;
constexpr size_t WS_WE13 = 158 * MiB;
constexpr size_t WS_WE2 = 510 * MiB;
constexpr size_t WS_X = 686 * MiB;
constexpr size_t WS_H = 758 * MiB;
constexpr size_t WS_Y = 794 * MiB;
constexpr size_t WS_P = 866 * MiB;
constexpr size_t WS_RST = 1001 * MiB;
constexpr size_t WS_HST = 1037 * MiB;
constexpr size_t WS_MST = 1055 * MiB;
constexpr size_t WS_MIX = 1077 * MiB;
constexpr size_t WS_U = 866 * MiB;
constexpr size_t WS_HG = 1113 * MiB;
constexpr size_t WS_YS = 1185 * MiB;
constexpr size_t WS_END = 1329 * MiB;
static_assert(WS_U + (size_t)18432 * DFF * 2 <= WS_HG, "U overlay");
constexpr int CW_BAR = 1024, CW_CNT = 8192;
constexpr int LDS_BYTES = 163840, MISC_OFF = LDS_BYTES - 512;

#define GAS __attribute__((address_space(1)))
#define LAS __attribute__((address_space(3)))
typedef unsigned short bf16;
typedef unsigned v4u __attribute__((ext_vector_type(4)));
typedef unsigned v2u __attribute__((ext_vector_type(2)));
typedef float f32x4 __attribute__((ext_vector_type(4)));
typedef short bf16x8 __attribute__((ext_vector_type(8)));
#define LDS_WAIT() asm volatile("s_waitcnt lgkmcnt(0)" ::: "memory")
#define VM_WAIT() asm volatile("s_waitcnt vmcnt(0)" ::: "memory")
__device__ __forceinline__ unsigned f2bf(float f) { unsigned u = __builtin_bit_cast(unsigned, f); return (u + 0x7fffu + ((u >> 16) & 1u)) >> 16; }
__device__ __forceinline__ unsigned pk2(float lo, float hi) { return f2bf(lo) | (f2bf(hi) << 16); }
__device__ __forceinline__ float bf2f(unsigned b) { return __builtin_bit_cast(float, b << 16); }
__device__ __forceinline__ float bflo(unsigned w) { return __builtin_bit_cast(float, w << 16); }
__device__ __forceinline__ float bfhi(unsigned w) { return __builtin_bit_cast(float, w & 0xffff0000u); }
__device__ __forceinline__ float wave_sum(float v) {
#pragma unroll
    for (int o = 1; o < 64; o <<= 1) v += __shfl_xor(v, o);
    return v;
}
__device__ __forceinline__ float wave_max(float v) {
#pragma unroll
    for (int o = 1; o < 64; o <<= 1) v = fmaxf(v, __shfl_xor(v, o));
    return v;
}
__device__ __forceinline__ float sum16(float v) { v += __shfl_xor(v, 1); v += __shfl_xor(v, 2); v += __shfl_xor(v, 4); v += __shfl_xor(v, 8); return v; }
__device__ __forceinline__ float sigmoidf_(float x) { return 1.0f / (1.0f + __expf(-x)); }
__device__ __forceinline__ float siluf_(float x) { return x / (1.0f + __expf(-x)); }
__device__ __forceinline__ float logsigmoidf_(float x) { return fminf(x, 0.0f) - log1pf(__expf(-fabsf(x))); }
__device__ __forceinline__ bf16x8 ldsfrag(const LAS unsigned char* base, int row, int pitch, int kk, int fq) { return *(const LAS bf16x8*)(base + row * pitch + kk * 64 + fq * 16); }
#define MFMA(a, b, c) __builtin_amdgcn_mfma_f32_16x16x32_bf16((a), (b), (c), 0, 0, 0)
constexpr int PIT = 272;

#define XB_TMO      128
#define XB_XCNT(j)  (256  + 64 * (j))
#define XB_XSUB(j)  (1280 + 64 * (j))
#define XB_XGEN(j)  (2304 + 64 * (j))
#define XB_TOP      3328
#define XB_TOPGEN   3392
#define XCD_BAR_WORDS 3456
#define XB_SPIN_CAP (1u << 18)
__device__ __forceinline__ unsigned xb_ld(unsigned* p)              { return __hip_atomic_load(p, __ATOMIC_RELAXED, __HIP_MEMORY_SCOPE_AGENT); }
__device__ __forceinline__ unsigned xb_add(unsigned* p, unsigned v) { return __hip_atomic_fetch_add(p, v, __ATOMIC_RELAXED, __HIP_MEMORY_SCOPE_AGENT); }
__device__ __forceinline__ unsigned xb_xcc_id() { return (unsigned)__builtin_amdgcn_s_getreg((3 << 11) | 20) & 0xFu; }
#define XB_SPIN(cond, bar) do { unsigned _sp = 0; while (cond) { __builtin_amdgcn_s_sleep(1); \
    if ((++_sp & 255u) == 0u) { if (xb_ld(&(bar)[XB_TMO])) break; if (_sp > XB_SPIN_CAP) { atomicAdd(&(bar)[XB_TMO], 1u); break; } } } } while (0)
struct XcdBarrier { unsigned* bar; unsigned x; volatile LAS unsigned* st; };
__device__ __forceinline__ XcdBarrier xcd_barrier_post(unsigned* bar, volatile LAS unsigned* st) {
    XcdBarrier b; b.bar = bar; b.x = xb_xcc_id(); b.st = st;
    if (threadIdx.x == 0) (void)xb_add(&bar[XB_XCNT(b.x)], 1u);
    return b;
}
__device__ __forceinline__ void xcd_barrier_complete(unsigned* bar, unsigned x, unsigned& nloc, unsigned& nx) {
    const unsigned G = gridDim.x * gridDim.y * gridDim.z;
    unsigned sum, cnt, mine, sp = 0u;
    for (;;) {
        sum = 0u; cnt = 0u; mine = 0u;
#pragma unroll
        for (unsigned j = 0; j < 16; ++j) { const unsigned c = xb_ld(&bar[XB_XCNT(j)]); sum += c; cnt += (c > 0u) ? 1u : 0u; mine = (j == x) ? c : mine; }
        if (sum == G) break;
        __builtin_amdgcn_s_sleep(1);
        if ((++sp & 255u) == 0u) { if (xb_ld(&bar[XB_TMO])) break; if (sp > XB_SPIN_CAP) { atomicAdd(&bar[XB_TMO], 1u); break; } }
    }
    nloc = mine > 0u ? mine : 1u; nx = cnt > 0u ? cnt : 1u;
}
__device__ __forceinline__ void xcd_barrier(const XcdBarrier& b) {
    asm volatile("s_waitcnt vmcnt(0)" ::: "memory");
    __syncthreads();
    if (threadIdx.x == 0) {
        unsigned* bar = b.bar;
        __builtin_amdgcn_s_waitcnt(0);
        unsigned nloc = b.st[0], nx = b.st[1];
        if (nloc == 0u) { xcd_barrier_complete(bar, b.x, nloc, nx); b.st[0] = nloc; b.st[1] = nx; }
        const unsigned old = xb_add(&bar[XB_XSUB(b.x)], 1u);
        const unsigned gen = old / nloc;
        if (old + 1u == (gen + 1u) * nloc) {
            __builtin_amdgcn_fence(__ATOMIC_RELEASE, "agent");
            asm volatile("s_waitcnt vmcnt(0)" ::: "memory");
            const unsigned og = xb_add(&bar[XB_TOP], 1u);
            const unsigned tg = og / nx;
            if (og + 1u == (tg + 1u) * nx) xb_add(&bar[XB_TOPGEN], 1u);
            else XB_SPIN(xb_ld(&bar[XB_TOPGEN]) == tg, bar);
            __builtin_amdgcn_fence(__ATOMIC_ACQUIRE, "agent");
            xb_add(&bar[XB_XGEN(b.x)], 1u);
            asm volatile("s_waitcnt vmcnt(0)" ::: "memory");
        } else {
            XB_SPIN(xb_ld(&bar[XB_XGEN(b.x)]) == gen, bar);
            __builtin_amdgcn_fence(__ATOMIC_ACQUIRE, "agent");
            asm volatile("s_waitcnt vmcnt(0)" ::: "memory");
        }
    }
    __syncthreads();
}

struct Ctx {
    LAS unsigned char* lds;
    int tid, lane, wave, G, bx;
    const float *x, *c, *ctx, *c_ctx, *w_ada, *b_ada, *norm_g, *w_in, *w_out, *ret_decay, *ret_gn, *hgrn_lb, *hgrn_gn, *mlstm_conv, *mlstm_gate_b, *mlstm_gn,
                *w_ffn1, *w_ffn3, *w_ffn2, *w_router, *w_exp1, *w_exp3, *w_exp2;
    float* out; unsigned char* ws;
};
#define WSP(T, off) ((T*)(C.ws + (off)))
__device__ __forceinline__ void tr_item(const float* W, int Npitch, bf16* WT, int Kd, int k0, int n0, int drow0, LAS float* scr, int lane) {
#pragma unroll 8
    for (int i = 0; i < 32; ++i) { const int kk = 2 * i + (lane >> 5); scr[kk * 33 + (lane & 31)] = W[(size_t)(k0 + kk) * Npitch + n0 + (lane & 31)]; }
    LDS_WAIT(); asm volatile("" ::: "memory");
    const int c = lane & 7;
#pragma unroll
    for (int j = 0; j < 4; ++j) { const int n = (lane >> 3) + 8 * j; const LAS float* s = scr + (8 * c) * 33 + n;
        v4u o; o.x = pk2(s[0 * 33], s[1 * 33]); o.y = pk2(s[2 * 33], s[3 * 33]); o.z = pk2(s[4 * 33], s[5 * 33]); o.w = pk2(s[6 * 33], s[7 * 33]);
        *(v4u*)(WT + (size_t)(drow0 + n) * Kd + k0 + 8 * c) = o; }
    LDS_WAIT(); asm volatile("" ::: "memory");
}
__device__ __forceinline__ void phase_prologue(const Ctx& C) {
    LAS float* scr = (LAS float*)(C.lds + C.wave * 16384);
    int lane0 = C.lane; asm volatile("" : "+v"(lane0));
    const int gw = C.bx * NWAVES + C.wave, NGW = C.G * NWAVES, lane = lane0;
    constexpr int N_ADA = 2 * 16 * 48;
    constexpr int I_IN = 32 * 240, I_OUT = 32 * 64, I_F = 5632;
    constexpr int N_TR = 2 * I_IN + 2 * I_OUT + 27 * I_F;
    for (int it = gw; it < N_ADA + N_TR; it += NGW) {
        if (it < N_ADA) {
            const int layer = it / 768, slice = (it % 768) / 48, cb = it % 48, k0 = slice * 128, c0 = cb * 256 + 4 * lane;
#pragma unroll
            for (int j = 0; j < 10; ++j) { const int idx = lane + 64 * j, v = idx >> 7, k = idx & 127; const float s = v < 4 ? C.c[v * D + k0 + k] : C.c_ctx[k0 + k]; scr[idx] = siluf_(s); }
            LDS_WAIT(); asm volatile("" ::: "memory");
            f32x4 acc[5];
#pragma unroll
            for (int v = 0; v < 5; ++v) acc[v] = (f32x4){0.f, 0.f, 0.f, 0.f};
            const float* wp = C.w_ada + ((size_t)layer * D + k0) * 12288 + c0;
#pragma unroll 8
            for (int k = 0; k < 128; ++k) { const f32x4 w = *(const f32x4*)(wp + (size_t)k * 12288);
#pragma unroll
                for (int v = 0; v < 5; ++v) acc[v] += w * scr[v * 128 + k]; }
            float* mp = WSP(float, WS_MODP) + ((size_t)(layer * 16 + slice) * 5) * 12288 + c0;
#pragma unroll
            for (int v = 0; v < 5; ++v) *(f32x4*)(mp + (size_t)v * 12288) = acc[v];
            LDS_WAIT(); asm volatile("" ::: "memory");
            continue;
        }
        int r = it - N_ADA;
        if (r < 2 * I_IN) { const int l = r / I_IN, q = r % I_IN, kb = q / 240, nb = q % 240;
            tr_item(C.w_in + (size_t)l * D * NPW, NPW, WSP(bf16, WS_WIN) + (size_t)l * NP * D, D, 64 * kb, 32 * nb, 32 * nb, scr, lane); continue; }
        r -= 2 * I_IN;
        if (r < 2 * I_OUT) { const int l = r / I_OUT, q = r % I_OUT, kb = q / 64, nb = q % 64;
            tr_item(C.w_out + (size_t)l * D * D, D, WSP(bf16, WS_WOUT) + (size_t)l * D * D, D, 64 * kb, 32 * nb, 32 * nb, scr, lane); continue; }
        r -= 2 * I_OUT;
        const int m = r / I_F, q = r % I_F;
        const bool down = (m == 2) || (m >= 19);
        if (!down) {
            const int half = (m == 1 || (m >= 11 && m < 19)) ? 1 : 0;
            const int e = m < 3 ? -1 : (m < 11 ? m - 3 : m - 11);
            const float* src = e < 0 ? (half ? C.w_ffn3 : C.w_ffn1) : (half ? C.w_exp3 : C.w_exp1) + (size_t)e * D * DFF;
            bf16* dst = e < 0 ? WSP(bf16, WS_WF13) : WSP(bf16, WS_WE13) + (size_t)e * 2 * DFF * D;
            const int kb = q / 176, nb = q % 176, n0 = 32 * nb, drow0 = (n0 >> 7) * 256 + (n0 & 127) + 128 * half;
            tr_item(src, DFF, dst, D, 64 * kb, n0, drow0, scr, lane);
        } else {
            const int e = m == 2 ? -1 : m - 19;
            const float* src = e < 0 ? C.w_ffn2 : C.w_exp2 + (size_t)e * DFF * D;
            bf16* dst = e < 0 ? WSP(bf16, WS_WF2) : WSP(bf16, WS_WE2) + (size_t)e * D * DFF;
            const int kb = q / 64, nb = q % 64;
            tr_item(src, D, dst, DFF, 64 * kb, 32 * nb, 32 * nb, scr, lane);
        }
    }
}
__device__ __forceinline__ f32x4 modsum(const Ctx& C, int l, int v, int j, int col4) {
    f32x4 s = *(const f32x4*)(C.b_ada + (size_t)l * 12288 + j * D + col4);
    const float* mp = WSP(float, WS_MODP) + ((size_t)(l * 16) * 5 + v) * 12288 + j * D + col4;
#pragma unroll 4
    for (int sl = 0; sl < 16; ++sl) s += *(const f32x4*)(mp + (size_t)sl * 5 * 12288);
    return s;
}
__device__ __forceinline__ void expert_offsets(const Ctx& C, int (&cnt)[8], int (&off)[9]) {
    const unsigned* ctl = WSP(unsigned, WS_CTL);
    off[0] = 0;
#pragma unroll
    for (int e = 0; e < 8; ++e) { cnt[e] = (int)__hip_atomic_load(ctl + CW_CNT + 64 * e, __ATOMIC_RELAXED, __HIP_MEMORY_SCOPE_AGENT); off[e + 1] = off[e] + ((cnt[e] + 255) & ~255); }
}
template <int MODE> __device__ __forceinline__ void row_phase(const Ctx& C, int layer) {
    constexpr bool UPD = MODE != 0, NRM = MODE != 3, GATES = (MODE == 0 || MODE == 2);
    const bool ROUTER = (MODE == 1 && layer == 1), lat_only = (MODE == 3) || ROUTER, from_inputs = (MODE == 0) || (MODE == 1 && layer == 0);
    const int lu = (MODE == 2) ? 0 : layer, ju = (MODE == 1) ? 2 : 5, ku = (MODE == 1) ? 1 : 3;
    const int ln = (MODE == 2) ? 1 : layer, kn = (MODE == 1) ? 2 : 0, jsh = (MODE == 1) ? 3 : 0, jsc = (MODE == 1) ? 4 : 1;
    LAS float* GV = (LAS float*)C.lds; LAS float* AV = GV + 2048; LAS float* BV = GV + 4096; LAS float* WG = GV + 6144;
    int tid0 = C.tid; asm volatile("" : "+v"(tid0));
    const int tid = tid0, lane = tid & 63, wave = C.wave;
    float* X = WSP(float, WS_X); const float* Y = WSP(float, WS_Y); bf16* H = WSP(bf16, WS_H);
    __syncthreads();
    if (GATES) { const float* wi = C.w_in + (size_t)ln * D * NPW + NP;
        for (int idx = tid; idx < D * 16; idx += NTHR) { const int col = idx >> 4, g = idx & 15; WG[g * D + col] = wi[(size_t)col * NPW + g]; } }
    if (ROUTER) { for (int idx = tid; idx < D * 8; idx += NTHR) { const int col = idx >> 3, e = idx & 7; WG[e * D + col] = C.w_router[idx]; } }
    int cnt[8], off[9];
    if (MODE == 3) expert_offsets(C, cnt, off);
    for (int chunk = C.bx; chunk < 256; chunk += C.G) {
        const int b = chunk >> 6;
        int nrows, rbase, nctx;
        if (lat_only) { nrows = 32; rbase = b * TB + LC + (chunk & 63) * 32; nctx = 0; }
        else { nrows = 36; rbase = chunk * 36; nctx = b * TB + LC - rbase; nctx = nctx < 0 ? 0 : (nctx > 36 ? 36 : nctx); }
        for (int seg = 0; seg < 2; ++seg) {
            const int i0 = seg ? nctx : 0, i1 = seg ? nrows : nctx;
            if (i0 >= i1) continue;
            const int v = seg ? b : 4, col4 = tid * 4;
            __syncthreads();
            if (UPD) { const f32x4 g = modsum(C, lu, v, ju, col4) * *(const f32x4*)(C.norm_g + (size_t)(lu * 4 + ku) * D + col4); *(LAS f32x4*)(GV + col4) = g; }
            if (NRM) { const f32x4 sc = modsum(C, ln, v, jsc, col4), sh = modsum(C, ln, v, jsh, col4);
                *(LAS f32x4*)(AV + col4) = *(const f32x4*)(C.norm_g + (size_t)(ln * 4 + kn) * D + col4) * (sc + 1.0f); *(LAS f32x4*)(BV + col4) = sh; }
            __syncthreads();
            for (int i = i0 + wave; i < i1; i += NWAVES) {
                const int row = rbase + i, tin = row - b * TB;
                const float* xsrc = from_inputs ? (tin < LC ? C.ctx + ((size_t)b * LC + tin) * D : C.x + ((size_t)b * SEQ + (tin - LC)) * D) : X + (size_t)row * D;
                f32x4 xv[8];
#pragma unroll
                for (int j = 0; j < 8; ++j) xv[j] = *(const f32x4*)(xsrc + 4 * lane + 256 * j);
                if (UPD) {
                    f32x4 yv[8];
                    if (MODE == 3) {
                        const int tok = b * SEQ + (tin - LC);
                        const int* ti = WSP(int, WS_TOKINFO) + (size_t)tok * 8;
                        const int e0 = ti[0], p0 = ti[1], e1 = ti[2], p1 = ti[3]; const float g0 = __builtin_bit_cast(float, ti[4]), g1 = __builtin_bit_cast(float, ti[5]);
                        int o0 = 0, o1 = 0;
#pragma unroll
                        for (int e = 0; e < 8; ++e) { o0 = (e0 == e) ? off[e] : o0; o1 = (e1 == e) ? off[e] : o1; }
                        const float* y0 = WSP(float, WS_YS) + (size_t)(o0 + p0) * D; const float* y1 = WSP(float, WS_YS) + (size_t)(o1 + p1) * D;
#pragma unroll
                        for (int j = 0; j < 8; ++j) yv[j] = *(const f32x4*)(y0 + 4 * lane + 256 * j) * g0 + *(const f32x4*)(y1 + 4 * lane + 256 * j) * g1;
                    } else {
#pragma unroll
                        for (int j = 0; j < 8; ++j) yv[j] = *(const f32x4*)(Y + (size_t)row * D + 4 * lane + 256 * j);
                    }
                    float ss = 0.f;
#pragma unroll
                    for (int j = 0; j < 8; ++j) ss += (yv[j].x * yv[j].x + yv[j].y * yv[j].y) + (yv[j].z * yv[j].z + yv[j].w * yv[j].w);
                    const float rs = 1.0f / sqrtf(wave_sum(ss) * (1.0f / D) + NORM_EPS);
                    float* xdst = (MODE == 3) ? C.out + ((size_t)b * SEQ + (tin - LC)) * D : X + (size_t)row * D;
#pragma unroll
                    for (int j = 0; j < 8; ++j) { xv[j] += *(const LAS f32x4*)(GV + 4 * lane + 256 * j) * (yv[j] * rs); *(f32x4*)(xdst + 4 * lane + 256 * j) = xv[j]; }
                }
                if (NRM) {
                    float ss = 0.f;
#pragma unroll
                    for (int j = 0; j < 8; ++j) ss += (xv[j].x * xv[j].x + xv[j].y * xv[j].y) + (xv[j].z * xv[j].z + xv[j].w * xv[j].w);
                    const float rs = 1.0f / sqrtf(wave_sum(ss) * (1.0f / D) + NORM_EPS);
#pragma unroll
                    for (int j = 0; j < 8; ++j) { xv[j] = (xv[j] * rs) * *(const LAS f32x4*)(AV + 4 * lane + 256 * j) + *(const LAS f32x4*)(BV + 4 * lane + 256 * j);
                        v2u w; w.x = pk2(xv[j].x, xv[j].y); w.y = pk2(xv[j].z, xv[j].w); *(v2u*)(H + (size_t)row * D + 4 * lane + 256 * j) = w; }
                    if (GATES) {
                        float outv = 0.f;
#pragma unroll 1
                        for (int g = 0; g < 16; ++g) { float a = 0.f;
#pragma unroll
                            for (int j = 0; j < 8; ++j) { const f32x4 w = *(const LAS f32x4*)(WG + g * D + 4 * lane + 256 * j); a += (xv[j].x * w.x + xv[j].y * w.y) + (xv[j].z * w.z + xv[j].w * w.w); }
                            a = wave_sum(a); outv = (lane == g) ? a : outv; }
                        if (lane < 16) WSP(float, WS_G16)[(size_t)row * 16 + lane] = outv;
                    }
                    if (ROUTER) {
                        int e0 = 0, e1 = 0; float v0 = -3.0e38f, v1 = -3.0e38f;
#pragma unroll 1
                        for (int e = 0; e < 8; ++e) { float a = 0.f;
#pragma unroll
                            for (int j = 0; j < 8; ++j) { const f32x4 w = *(const LAS f32x4*)(WG + e * D + 4 * lane + 256 * j); a += (xv[j].x * w.x + xv[j].y * w.y) + (xv[j].z * w.z + xv[j].w * w.w); }
                            a = wave_sum(a);
                            if (a > v0) { v1 = v0; e1 = e0; v0 = a; e0 = e; } else if (a > v1) { v1 = a; e1 = e; } }
                        if (lane == 0) {
                            const float g1 = 1.0f / (1.0f + __expf(v0 - v1)), g0 = 1.0f - g1;
                            unsigned* ctl = WSP(unsigned, WS_CTL);
                            const int tok = b * SEQ + (tin - LC);
                            const int p0 = (int)__hip_atomic_fetch_add(ctl + CW_CNT + 64 * e0, 1u, __ATOMIC_RELAXED, __HIP_MEMORY_SCOPE_AGENT);
                            const int p1 = (int)__hip_atomic_fetch_add(ctl + CW_CNT + 64 * e1, 1u, __ATOMIC_RELAXED, __HIP_MEMORY_SCOPE_AGENT);
                            WSP(int, WS_LIST)[e0 * 8192 + p0] = tok; WSP(int, WS_LIST)[e1 * 8192 + p1] = tok;
                            int* ti = WSP(int, WS_TOKINFO) + (size_t)tok * 8;
                            ti[0] = e0; ti[1] = p0; ti[2] = e1; ti[3] = p1; ti[4] = __builtin_bit_cast(int, g0); ti[5] = __builtin_bit_cast(int, g1);
                        }
                    }
                }
            }
        }
    }
    __syncthreads();
}
__device__ __forceinline__ void phase_gather(const Ctx& C) {
    int cnt[8], off[9]; expert_offsets(C, cnt, off);
    int lane0 = C.lane; asm volatile("" : "+v"(lane0));
    const int gw = C.bx * NWAVES + C.wave, NGW = C.G * NWAVES, lane = lane0;
    const bf16* H = WSP(bf16, WS_H); bf16* HG = WSP(bf16, WS_HG);
    for (int slot = gw; slot < off[8]; slot += NGW) {
        int e = 0, oe = 0, ce = cnt[0];
#pragma unroll
        for (int j = 1; j < 8; ++j) if (slot >= off[j]) { e = j; oe = off[j]; ce = cnt[j]; }
        const int pos = slot - oe;
        v4u d[4];
        if (pos < ce) { const int tok = WSP(int, WS_LIST)[e * 8192 + pos]; const size_t row = (size_t)(tok >> 11) * TB + LC + (tok & 2047);
#pragma unroll
            for (int j = 0; j < 4; ++j) d[j] = *(const v4u*)(H + row * D + 8 * lane + 512 * j);
        } else {
#pragma unroll
            for (int j = 0; j < 4; ++j) d[j] = (v4u){0u, 0u, 0u, 0u};
        }
#pragma unroll
        for (int j = 0; j < 4; ++j) *(v4u*)(HG + (size_t)slot * D + 8 * lane + 512 * j) = d[j];
    }
}
#ifndef GRPMASK
#define GRPMASK 7
#endif
__device__ __forceinline__ int chain_chunk(int dir, int step) { return dir == 0 ? step : (step == 0 ? 1 : (step == 1 ? 0 : 19 - step)); }
__device__ __forceinline__ void unpack8(const v4u w, float (&f)[8]) { f[0] = bflo(w.x); f[1] = bfhi(w.x); f[2] = bflo(w.y); f[3] = bfhi(w.y); f[4] = bflo(w.z); f[5] = bfhi(w.z); f[6] = bflo(w.w); f[7] = bfhi(w.w); }
__device__ __forceinline__ void store_state_tile(bf16* ST, int e, int d0, const f32x4 s) { v2u w; w.x = pk2(s[0], s[1]); w.y = pk2(s[2], s[3]); *(v2u*)(ST + (size_t)e * 128 + d0) = w; }
__device__ __forceinline__ void rotary16(float (&x1)[16], float (&x2)[16], int g, int tl, const LAS float* inv) {
    const float pos = (float)((g < 2) ? (tl >> 6) : (tl & 63));
#pragma unroll
    for (int i = 0; i < 16; ++i) { const float ang = pos * inv[16 * (g & 1) + i]; const float sn = __sinf(ang), cs = __cosf(ang); const float a = x1[i], b = x2[i]; x1[i] = a * cs - b * sn; x2[i] = b * cs + a * sn; }
}
__device__ __forceinline__ float scan_wave_sum(float v, int lane, bool bwd) {
#pragma unroll
    for (int o = 1; o < 64; o <<= 1) { const float t = bwd ? __shfl_down(v, o) : __shfl_up(v, o); const bool ok = bwd ? (lane + o < 64) : (lane >= o); v += ok ? t : 0.f; }
    return v;
}
__device__ __forceinline__ float scan_wave_max(float v, int lane, bool bwd) {
#pragma unroll
    for (int o = 1; o < 64; o <<= 1) { const float t = bwd ? __shfl_down(v, o) : __shfl_up(v, o); const bool ok = bwd ? (lane + o < 64) : (lane >= o); v = ok ? fmaxf(v, t) : v; }
    return v;
}
struct RawStep { v4u a[12]; v4u v[2]; float g0, g1; };
__device__ __forceinline__ void state_load(RawStep& R, const Ctx& C, int grp, int b, int h, int dir, int es, int c, int s, int g) {
    const bf16* P = WSP(bf16, WS_P);
    const size_t row = (size_t)b * TB + 128 * c + s;
    const bf16* prow = P + row * NP;
    if (grp == 0) { const bf16* kp = prow + 512 + h * 128 + 16 * g;
        R.a[0] = *(const v4u*)kp; R.a[1] = *(const v4u*)(kp + 8); R.a[2] = *(const v4u*)(kp + 64); R.a[3] = *(const v4u*)(kp + 72);
        const bf16* vp = prow + 1024 + h * 256 + 64 * es + 16 * g; R.v[0] = *(const v4u*)vp; R.v[1] = *(const v4u*)(vp + 8);
    } else if (grp == 1) { const bf16* fp = prow + 3584 + dir * 512 + h * 128 + 32 * g;
#pragma unroll
        for (int q = 0; q < 4; ++q) R.a[q] = *(const v4u*)(fp + 8 * q);
        const bf16* vp = prow + 4608 + h * 128 + 64 * es + 16 * g; R.v[0] = *(const v4u*)vp; R.v[1] = *(const v4u*)(vp + 8);
    } else { const bf16* kp = prow + 6144 + h * 128 + 32 * g;
        const int tall = 128 * c + s, seg0 = c < 2 ? 0 : LC, seg1 = c < 2 ? LC : TB;
        const bool hp = tall - 1 >= seg0, hn = tall + 1 < seg1;
#pragma unroll
        for (int q = 0; q < 4; ++q) { R.a[q] = *(const v4u*)(kp + 8 * q);
            R.a[4 + q] = hp ? *(const v4u*)(kp - NP + 8 * q) : (v4u){0u, 0u, 0u, 0u};
            R.a[8 + q] = hn ? *(const v4u*)(kp + NP + 8 * q) : (v4u){0u, 0u, 0u, 0u}; }
        const bf16* vp = prow + 6656 + h * 128 + 64 * es + 16 * g; R.v[0] = *(const v4u*)vp; R.v[1] = *(const v4u*)(vp + 8);
        const float* gp = WSP(float, WS_G16) + row * 16; R.g0 = gp[8 + 4 * dir + h]; R.g1 = gp[4 * dir + h];
    }
}
__device__ __forceinline__ void phase_state(const Ctx& C, int layer) {
    LAS unsigned char* lds = C.lds;
    LAS unsigned char* KT = lds;
    LAS unsigned char* VT = lds + 34816;
    LAS float* LB = (LAS float*)(lds + 57344);
    LAS float* QT = (LAS float*)(lds + 124928);
    LAS float* SC = (LAS float*)(lds + 126976);
    const int w = C.wave, g = w >> 1;
    __syncthreads();
    if (C.tid < 32) SC[768 + C.tid] = __expf(-(float)C.tid * (9.210340371976184f / 32.0f));
    for (int ch = C.bx; ch < 256; ch += C.G) {
        const int grp = ch < 128 ? 0 : (ch < 192 ? 1 : 2);
        const int xx = grp == 0 ? ch : (grp == 1 ? ch - 128 : ch - 192);
        const int b = grp == 0 ? (xx >> 5) : (xx >> 4), h = grp == 0 ? ((xx >> 3) & 3) : ((xx >> 2) & 3), dir = grp == 0 ? ((xx >> 2) & 1) : ((xx >> 1) & 1), es = grp == 0 ? (xx & 3) : (xx & 1);
        f32x4 S[5];
#pragma unroll
        for (int i = 0; i < 5; ++i) S[i] = (f32x4){0.f, 0.f, 0.f, 0.f};
        __syncthreads();
        { const int tid = C.tid;
        if (grp == 1 && tid < 128) { const int chn = h * 128 + tid; SC[640 + tid] = layer == 0 ? 0.0f : sigmoidf_(C.hgrn_lb[512 + chn] - C.hgrn_lb[chn]); }
        if (grp == 2) { if (tid < 384) { const int j = tid >> 7, dd = tid & 127; SC[1024 + tid] = C.mlstm_conv[(size_t)layer * 3072 + j * 1024 + 512 + h * 128 + dd]; }
            for (int idx = tid; idx < 16 * 128; idx += NTHR) { const int er = idx >> 7, sc = idx & 127; *(LAS bf16*)(VT + (64 + er) * PIT + sc * 2) = (er == 0) ? (bf16)0x3F80 : (bf16)0; } } }
        const float lg = grp == 0 ? logsigmoidf_(C.ret_decay[layer * 8 + dir * 4 + h]) : 0.0f;
        const float gbf = grp == 2 ? C.mlstm_gate_b[layer * 16 + 8 + 4 * dir + h] : 0.f, gbi = grp == 2 ? C.mlstm_gate_b[layer * 16 + 4 * dir + h] : 0.f;
        float mrun = 0.0f;
        RawStep R;
        state_load(R, C, grp, b, h, dir, es, chain_chunk(dir, 0), C.tid & 127, g);
        __syncthreads();
        for (int step = 0; step < NCH; ++step) {
            int tid0 = C.tid; asm volatile("" : "+v"(tid0));
            const int tid = tid0, lane = tid & 63, fr = lane & 15, fq = lane >> 4, s = tid & 127;
            const int c = chain_chunk(dir, step);
            const RawStep X = R;
            if (step + 1 < NCH) state_load(R, C, grp, b, h, dir, es, chain_chunk(dir, step + 1), s, g);
            float decay_s = 1.0f;
            const unsigned vw[8] = {X.v[0].x, X.v[0].y, X.v[0].z, X.v[0].w, X.v[1].x, X.v[1].y, X.v[1].z, X.v[1].w};
#pragma unroll
            for (int i = 0; i < 8; ++i) { *(LAS bf16*)(VT + (16 * g + 2 * i) * PIT + s * 2) = (bf16)(vw[i] & 0xffffu); *(LAS bf16*)(VT + (16 * g + 2 * i + 1) * PIT + s * 2) = (bf16)(vw[i] >> 16); }
            if ((GRPMASK & 1) && grp == 0) {
                float k1[16], k2[16];
                { float t8[8];
                  unpack8(X.a[0], t8);
#pragma unroll
                  for (int i = 0; i < 8; ++i) k1[i] = t8[i];
                  unpack8(X.a[1], t8);
#pragma unroll
                  for (int i = 0; i < 8; ++i) k1[8 + i] = t8[i];
                  unpack8(X.a[2], t8);
#pragma unroll
                  for (int i = 0; i < 8; ++i) k2[i] = t8[i];
                  unpack8(X.a[3], t8);
#pragma unroll
                  for (int i = 0; i < 8; ++i) k2[8 + i] = t8[i]; }
                if (c >= 2) rotary16(k1, k2, g, 128 * (c - 2) + s, SC + 768);
                const int tau = dir ? 127 - s : s;
                const float wk = __expf((float)(127 - tau) * lg) * 0.08838834764831845f;
#pragma unroll
                for (int i = 0; i < 16; ++i) { *(LAS bf16*)(KT + (16 * g + i) * PIT + s * 2) = (bf16)f2bf(k1[i] * wk); *(LAS bf16*)(KT + (64 + 16 * g + i) * PIT + s * 2) = (bf16)f2bf(k2[i] * wk); }
                decay_s = __expf(128.0f * lg);
            } else if ((GRPMASK & 2) && grp == 1) {
#pragma unroll
                for (int q = 0; q < 4; ++q) { float t8[8]; unpack8(X.a[q], t8); float lf8[8];
#pragma unroll
                    for (int i = 0; i < 8; ++i) { const float x = t8[i], lbv = SC[640 + 32 * g + 8 * q + i], ex = __expf(-fabsf(x)), r = 1.0f / (1.0f + ex);
                        const float sg = x >= 0.f ? r : ex * r, sgm = x >= 0.f ? ex * r : r;
                        lf8[i] = __logf(lbv + (1.0f - lbv) * sg); *(LAS bf16*)(KT + (32 * g + 8 * q + i) * PIT + s * 2) = (bf16)f2bf((1.0f - lbv) * sgm); }
                    *(LAS f32x4*)(LB + s * 132 + 32 * g + 8 * q) = (f32x4){lf8[0], lf8[1], lf8[2], lf8[3]};
                    *(LAS f32x4*)(LB + s * 132 + 32 * g + 8 * q + 4) = (f32x4){lf8[4], lf8[5], lf8[6], lf8[7]}; }
                __syncthreads();
                { const int dq = tid & 127, q4 = tid >> 7; float run = 0.f;
                  for (int i = 0; i < 32; ++i) { const int ss = dir ? (32 * q4 + 31 - i) : (32 * q4 + i); run += LB[ss * 132 + dq]; LB[ss * 132 + dq] = run; }
                  QT[q4 * 128 + dq] = run; }
                __syncthreads();
                { const int q4s = s >> 5;
#pragma unroll 4
                  for (int i = 0; i < 32; ++i) { const int dd = 32 * g + i; const float t0 = QT[dd], t1 = QT[128 + dd], t2 = QT[256 + dd], t3 = QT[384 + dd];
                      float offv;
                      if (dir == 0) offv = (q4s > 0 ? t0 : 0.f) + (q4s > 1 ? t1 : 0.f) + (q4s > 2 ? t2 : 0.f);
                      else offv = (q4s < 3 ? t3 : 0.f) + (q4s < 2 ? t2 : 0.f) + (q4s < 1 ? t1 : 0.f);
                      const float bb = LB[s * 132 + dd] + offv, bl = (t0 + t1) + (t2 + t3);
                      LAS bf16* kp2 = (LAS bf16*)(KT + dd * PIT + s * 2); *kp2 = (bf16)f2bf(bf2f(*kp2) * __expf(bl - bb)); } }
            } else if ((GRPMASK & 4) && grp == 2) {
                float bsc = 0.f, igv = 0.f;
                if (tid < 128) { igv = X.g1 + gbi; bsc = scan_wave_sum(logsigmoidf_(X.g0 + gbf), lane, dir != 0); if (lane == (dir ? 0 : 63)) SC[512 + w] = bsc; }
                __syncthreads();
                const float bl = SC[512] + SC[513];
                if (tid < 128) { if (dir == 0 ? (w == 1) : (w == 0)) bsc += SC[512 + (w ^ 1)];
                    const float be = bl - bsc + igv; SC[384 + s] = be; const float mx = wave_max(be); if (lane == 0) SC[516 + w] = mx; }
                __syncthreads();
                const float mloc = fmaxf(SC[516], SC[517]), mnew = fmaxf(bl + mrun, mloc);
                decay_s = __expf(bl + mrun - mnew);
                const float ws = __expf(SC[384 + s] - mnew) * 0.08838834764831845f;
#pragma unroll
                for (int q = 0; q < 4; ++q) { float a8[8], t8[8];
                    unpack8(X.a[q], t8);
#pragma unroll
                    for (int i = 0; i < 8; ++i) a8[i] = t8[i] * SC[1024 + 128 + 32 * g + 8 * q + i];
                    unpack8(X.a[4 + q], t8);
#pragma unroll
                    for (int i = 0; i < 8; ++i) a8[i] += t8[i] * SC[1024 + 32 * g + 8 * q + i];
                    unpack8(X.a[8 + q], t8);
#pragma unroll
                    for (int i = 0; i < 8; ++i) a8[i] += t8[i] * SC[1024 + 256 + 32 * g + 8 * q + i];
#pragma unroll
                    for (int i = 0; i < 8; ++i) *(LAS bf16*)(KT + (32 * g + 8 * q + i) * PIT + s * 2) = (bf16)f2bf(siluf_(a8[i]) * ws); }
                if (es == 0 && tid == 0) WSP(float, WS_MSM)[((b * 4 + h) * 2 + dir) * NCH + c] = mrun;
                mrun = mnew;
            }
            __syncthreads();
            const size_t sidx = (size_t)(((b * 4 + h) * 2 + dir) * NCH + c);
            const int d0 = 16 * w + 4 * fq;
            if (grp == 0) { bf16* ST = WSP(bf16, WS_RST) + sidx * (256 * 128);
#pragma unroll
                for (int ei = 0; ei < 4; ++ei) store_state_tile(ST, 64 * es + 16 * ei + fr, d0, S[ei]);
#pragma unroll
                for (int ei = 0; ei < 4; ++ei) S[ei] *= decay_s;
            } else if (grp == 1) { bf16* ST = WSP(bf16, WS_HST) + sidx * (128 * 128);
#pragma unroll
                for (int ei = 0; ei < 4; ++ei) store_state_tile(ST, 64 * es + 16 * ei + fr, d0, S[ei]);
                f32x4 dv;
#pragma unroll
                for (int r = 0; r < 4; ++r) { const int dd = d0 + r; dv[r] = __expf((QT[dd] + QT[128 + dd]) + (QT[256 + dd] + QT[384 + dd])); }
#pragma unroll
                for (int ei = 0; ei < 4; ++ei) S[ei] *= dv;
            } else { bf16* ST = WSP(bf16, WS_MST) + sidx * (144 * 128);
#pragma unroll
                for (int ei = 0; ei < 4; ++ei) store_state_tile(ST, 64 * es + 16 * ei + fr, d0, S[ei]);
                if (es == 0) store_state_tile(ST, 128 + fr, d0, S[4]);
#pragma unroll
                for (int ei = 0; ei < 5; ++ei) S[ei] *= decay_s;
            }
#pragma unroll
            for (int kk4 = 0; kk4 < 4; ++kk4) { const bf16x8 a = ldsfrag(KT, 16 * w + fr, PIT, kk4, fq);
#pragma unroll
                for (int ei = 0; ei < 4; ++ei) S[ei] = MFMA(a, ldsfrag(VT, 16 * ei + fr, PIT, kk4, fq), S[ei]);
                if (grp == 2) S[4] = MFMA(a, ldsfrag(VT, 64 + fr, PIT, kk4, fq), S[4]); }
            __syncthreads();
        }
    }
}
__device__ __forceinline__ void stage_vt128(LAS unsigned char* VT, const bf16* vp  , int g, int s) {
#pragma unroll
    for (int q = 0; q < 4; ++q) { const v4u v = *(const v4u*)(vp + 8 * q); const unsigned vw[4] = {v.x, v.y, v.z, v.w};
#pragma unroll
        for (int i = 0; i < 4; ++i) { *(LAS bf16*)(VT + (32 * g + 8 * q + 2 * i) * PIT + s * 2) = (bf16)(vw[i] & 0xffffu); *(LAS bf16*)(VT + (32 * g + 8 * q + 2 * i + 1) * PIT + s * 2) = (bf16)(vw[i] >> 16); } }
}
__device__ __forceinline__ void stage_rot16(LAS unsigned char* dst, const bf16* src, bool rot, int g, int tl, const LAS float* inv, float scale, int s) {
    float x1[16], x2[16], t8[8];
    unpack8(*(const v4u*)src, t8);
#pragma unroll
    for (int i = 0; i < 8; ++i) x1[i] = t8[i];
    unpack8(*(const v4u*)(src + 8), t8);
#pragma unroll
    for (int i = 0; i < 8; ++i) x1[8 + i] = t8[i];
    unpack8(*(const v4u*)(src + 64), t8);
#pragma unroll
    for (int i = 0; i < 8; ++i) x2[i] = t8[i];
    unpack8(*(const v4u*)(src + 72), t8);
#pragma unroll
    for (int i = 0; i < 8; ++i) x2[8 + i] = t8[i];
    if (rot) rotary16(x1, x2, g, tl, inv);
    v4u o;
    o.x = pk2(x1[0] * scale, x1[1] * scale); o.y = pk2(x1[2] * scale, x1[3] * scale); o.z = pk2(x1[4] * scale, x1[5] * scale); o.w = pk2(x1[6] * scale, x1[7] * scale); *(LAS v4u*)(dst + s * PIT + (16 * g) * 2) = o;
    o.x = pk2(x1[8] * scale, x1[9] * scale); o.y = pk2(x1[10] * scale, x1[11] * scale); o.z = pk2(x1[12] * scale, x1[13] * scale); o.w = pk2(x1[14] * scale, x1[15] * scale); *(LAS v4u*)(dst + s * PIT + (16 * g + 8) * 2) = o;
    o.x = pk2(x2[0] * scale, x2[1] * scale); o.y = pk2(x2[2] * scale, x2[3] * scale); o.z = pk2(x2[4] * scale, x2[5] * scale); o.w = pk2(x2[6] * scale, x2[7] * scale); *(LAS v4u*)(dst + s * PIT + (64 + 16 * g) * 2) = o;
    o.x = pk2(x2[8] * scale, x2[9] * scale); o.y = pk2(x2[10] * scale, x2[11] * scale); o.z = pk2(x2[12] * scale, x2[13] * scale); o.w = pk2(x2[14] * scale, x2[15] * scale); *(LAS v4u*)(dst + s * PIT + (64 + 16 * g + 8) * 2) = o;
    asm volatile("" ::: "memory");
}
template <int DV, int ACT> __device__ __forceinline__ void mix_store(const LAS unsigned char* OT, int OPB, const bf16* pgate  , const float* gn, bf16* mix  , int tid) {
    constexpr int CPR = DV / 8;
#pragma unroll
    for (int it = 0; it < (128 * CPR) / NTHR; ++it) { const int idx = tid + NTHR * it, row = idx / CPR, chn = idx % CPR;
        float o8[8], g8[8]; unpack8(*(const LAS v4u*)(OT + row * OPB + chn * 16), o8); unpack8(*(const v4u*)(pgate + (size_t)row * NP + chn * 8), g8);
        const f32x4 n0 = *(const f32x4*)(gn + chn * 8), n1 = *(const f32x4*)(gn + chn * 8 + 4);
        const float nn[8] = {n0[0], n0[1], n0[2], n0[3], n1[0], n1[1], n1[2], n1[3]};
        float r8[8];
#pragma unroll
        for (int i = 0; i < 8; ++i) r8[i] = o8[i] * nn[i] * (ACT == 0 ? siluf_(g8[i]) : sigmoidf_(g8[i]));
        v4u o; o.x = pk2(r8[0], r8[1]); o.y = pk2(r8[2], r8[3]); o.z = pk2(r8[4], r8[5]); o.w = pk2(r8[6], r8[7]);
        *(v4u*)(mix + (size_t)row * D + chn * 8) = o; }
}
__device__ __forceinline__ void phase_out(const Ctx& C, int layer) {
    LAS unsigned char* lds = C.lds;
    const int w = C.wave, g = w >> 1;
    const bf16* P = WSP(bf16, WS_P); bf16* MIX = WSP(bf16, WS_MIX);
    LAS float* SC = (LAS float*)(lds + 139264);
    __syncthreads();
    if (C.tid < 32) SC[2048 + C.tid] = __expf(-(float)C.tid * (9.210340371976184f / 32.0f));
    __syncthreads();
    constexpr int NU = 3 * NB * 4 * NCH;
    for (int u = C.bx; u < NU; u += C.G) {
        int tid0 = C.tid; asm volatile("" : "+v"(tid0));
        const int tid = tid0, lane = tid & 63, fr = lane & 15, fq = lane >> 4, s = tid & 127;
        const int grp = u / 288, uu = u % 288, b = uu / 72, h = (uu % 72) / NCH, c = uu % NCH;
        const size_t row0 = (size_t)b * TB + 128 * c;
        const bf16* prow = P + (row0 + s) * NP;
        const size_t sidx_f = (size_t)(((b * 4 + h) * 2 + 0) * NCH + c), sidx_b = (size_t)(((b * 4 + h) * 2 + 1) * NCH + c);
#ifndef GRPMASK
#define GRPMASK 7
#endif
        if ((GRPMASK & 1) && grp == 0) {
            LAS unsigned char* QL = lds; LAS unsigned char* KL = lds + 34816; LAS unsigned char* AL = lds + 69632; LAS unsigned char* VT = lds + 104448;
            const float lgf = logsigmoidf_(C.ret_decay[layer * 8 + h]), lgb = logsigmoidf_(C.ret_decay[layer * 8 + 4 + h]);
            stage_rot16(QL, prow + h * 128 + 16 * g, c >= 2, g, 128 * (c - 2) + s, SC + 2048, 1.0f, s);
            stage_rot16(KL, prow + 512 + h * 128 + 16 * g, c >= 2, g, 128 * (c - 2) + s, SC + 2048, 0.08838834764831845f, s);
            __syncthreads();
            bf16x8 qf[4];
#pragma unroll
            for (int kk = 0; kk < 4; ++kk) qf[kk] = ldsfrag(QL, 16 * w + fr, PIT, kk, fq);
            {   f32x4 sa[8];
#pragma unroll
                for (int j = 0; j < 8; ++j) sa[j] = (f32x4){0.f, 0.f, 0.f, 0.f};
#pragma unroll
                for (int kk = 0; kk < 4; ++kk)
#pragma unroll
                    for (int j = 0; j < 8; ++j) sa[j] = MFMA(qf[kk], ldsfrag(KL, 16 * j + fr, PIT, kk, fq), sa[j]);
#pragma unroll
                for (int j = 0; j < 8; ++j)
#pragma unroll
                    for (int r = 0; r < 4; ++r) { const int t = 16 * w + 4 * fq + r, ss = 16 * j + fr; const float dl = (float)(t - ss);
                        const float dm = (ss <= t ? __expf(dl * lgf) : 0.f) + (ss >= t ? __expf(-dl * lgb) : 0.f);
                        *(LAS bf16*)(AL + t * PIT + ss * 2) = (bf16)f2bf(sa[j][r] * dm); }
            }
            f32x4 o[2][8];
            float dqf[4], dqb[4];
#pragma unroll
            for (int r = 0; r < 4; ++r) { const int t = 16 * w + 4 * fq + r; dqf[r] = __expf((float)(t + 1) * lgf); dqb[r] = __expf((float)(128 - t) * lgb); }
#pragma unroll
            for (int half = 0; half < 2; ++half) {
                if (half == 1) __syncthreads();
                stage_vt128(VT, prow + 1024 + h * 256 + 128 * half + 32 * g, g, s);
                __syncthreads();
#pragma unroll
                for (int ei = 0; ei < 8; ++ei) o[half][ei] = (f32x4){0.f, 0.f, 0.f, 0.f};
#pragma unroll
                for (int kk = 0; kk < 4; ++kk) { const bf16x8 a = ldsfrag(AL, 16 * w + fr, PIT, kk, fq);
#pragma unroll
                    for (int ei = 0; ei < 8; ++ei) o[half][ei] = MFMA(a, ldsfrag(VT, 16 * ei + fr, PIT, kk, fq), o[half][ei]); }
#pragma unroll 1
                for (int dir = 0; dir < 2; ++dir) {
                    const bf16* ST = WSP(bf16, WS_RST) + (dir ? sidx_b : sidx_f) * (256 * 128) + (size_t)(128 * half) * 128 + (size_t)fr * 128 + 8 * fq;
                    f32x4 ia[8];
#pragma unroll
                    for (int ei = 0; ei < 8; ++ei) ia[ei] = (f32x4){0.f, 0.f, 0.f, 0.f};
#pragma unroll
                    for (int kk = 0; kk < 4; ++kk) {
#pragma unroll
                        for (int ei = 0; ei < 8; ++ei) { const bf16x8 bb = *(const bf16x8*)(ST + ei * 2048 + 32 * kk); ia[ei] = MFMA(qf[kk], bb, ia[ei]); }
                        __builtin_amdgcn_sched_barrier(0); }
#pragma unroll
                    for (int ei = 0; ei < 8; ++ei)
#pragma unroll
                        for (int r = 0; r < 4; ++r) o[half][ei][r] += (dir ? dqb[r] : dqf[r]) * ia[ei][r];
                }
            }
            float rs[4];
#pragma unroll
            for (int r = 0; r < 4; ++r) { float q = 0.f;
#pragma unroll
                for (int half = 0; half < 2; ++half)
#pragma unroll
                    for (int ei = 0; ei < 8; ++ei) q += o[half][ei][r] * o[half][ei][r];
                rs[r] = 1.0f / sqrtf(sum16(q) * (1.0f / 256.0f) + NORM_EPS); }
            __syncthreads();
#pragma unroll
            for (int half = 0; half < 2; ++half)
#pragma unroll
                for (int ei = 0; ei < 8; ++ei)
#pragma unroll
                    for (int r = 0; r < 4; ++r) *(LAS bf16*)(lds + (16 * w + 4 * fq + r) * 528 + (128 * half + 16 * ei + fr) * 2) = (bf16)f2bf(o[half][ei][r] * rs[r]);
            __syncthreads();
            mix_store<256, 0>(lds, 528, P + row0 * NP + 2048 + h * 256, C.ret_gn + layer * 1024 + h * 256, MIX + row0 * D + h * 256, tid);
            __syncthreads();
        } else if ((GRPMASK & 2) && grp == 1) {
            LAS float* BB = (LAS float*)lds;
            LAS unsigned char* QL = lds + 67584; LAS unsigned char* KL = lds + 102400;
            LAS float* QT = (LAS float*)(lds + 137216);
            LAS unsigned char* AL = lds; LAS unsigned char* VT = lds + 34816;
            if (tid < 128) { const int chn = h * 128 + tid; SC[tid] = layer == 0 ? 0.0f : sigmoidf_(C.hgrn_lb[512 + chn] - C.hgrn_lb[chn]); }
            __syncthreads();
            f32x4 oa[8], aa[8];
#pragma unroll
            for (int j = 0; j < 8; ++j) { oa[j] = (f32x4){0.f, 0.f, 0.f, 0.f}; aa[j] = (f32x4){0.f, 0.f, 0.f, 0.f}; }
#pragma unroll 1
            for (int dir = 0; dir < 2; ++dir) {
                {   const bf16* fp = prow + 3584 + dir * 512 + h * 128 + 32 * g; const bf16* qp = prow + 3072 + h * 128 + 32 * g;
#pragma unroll 1
                    for (int q = 0; q < 4; ++q) { float t8[8], lf8[8], k8[8]; unpack8(*(const v4u*)(fp + 8 * q), t8);
#pragma unroll
                        for (int i = 0; i < 8; ++i) { const float x = t8[i], lbv = SC[32 * g + 8 * q + i], ex = __expf(-fabsf(x)), rr = 1.0f / (1.0f + ex);
                            const float sg = x >= 0.f ? rr : ex * rr, sgm = x >= 0.f ? ex * rr : rr;
                            lf8[i] = logf(lbv + (1.0f - lbv) * sg); k8[i] = (1.0f - lbv) * sgm; }
                        *(LAS f32x4*)(BB + s * 132 + 32 * g + 8 * q) = (f32x4){lf8[0], lf8[1], lf8[2], lf8[3]};
                        *(LAS f32x4*)(BB + s * 132 + 32 * g + 8 * q + 4) = (f32x4){lf8[4], lf8[5], lf8[6], lf8[7]};
                        v4u o4; o4.x = pk2(k8[0], k8[1]); o4.y = pk2(k8[2], k8[3]); o4.z = pk2(k8[4], k8[5]); o4.w = pk2(k8[6], k8[7]);
                        *(LAS v4u*)(KL + s * PIT + (32 * g + 8 * q) * 2) = o4;
                        if (dir == 0) { unpack8(*(const v4u*)(qp + 8 * q), t8);
                            o4.x = pk2(siluf_(t8[0]), siluf_(t8[1])); o4.y = pk2(siluf_(t8[2]), siluf_(t8[3])); o4.z = pk2(siluf_(t8[4]), siluf_(t8[5])); o4.w = pk2(siluf_(t8[6]), siluf_(t8[7]));
                            *(LAS v4u*)(QL + s * PIT + (32 * g + 8 * q) * 2) = o4; } }
                }
                __syncthreads();
                { const int dq = tid & 127, q4 = tid >> 7; float run = 0.f;
                  for (int i = 0; i < 32; ++i) { const int ss = dir ? (32 * q4 + 31 - i) : (32 * q4 + i); run += BB[ss * 132 + dq]; BB[ss * 132 + dq] = run; }
                  QT[q4 * 128 + dq] = run; }
                __syncthreads();
                { const int q4s = s >> 5;
#pragma unroll 2
                  for (int q = 0; q < 8; ++q) { f32x4 v = *(LAS f32x4*)(BB + s * 132 + 32 * g + 4 * q);
#pragma unroll
                      for (int i = 0; i < 4; ++i) { const int dd = 32 * g + 4 * q + i; const float t0 = QT[dd], t1 = QT[128 + dd], t2 = QT[256 + dd], t3 = QT[384 + dd];
                          float offv;
                          if (dir == 0) offv = (q4s > 0 ? t0 : 0.f) + (q4s > 1 ? t1 : 0.f) + (q4s > 2 ? t2 : 0.f);
                          else offv = (q4s < 3 ? t3 : 0.f) + (q4s < 2 ? t2 : 0.f) + (q4s < 1 ? t1 : 0.f);
                          v[i] += offv; }
                      *(LAS f32x4*)(BB + s * 132 + 32 * g + 4 * q) = v; } }
                __syncthreads();
                {   const int i = w, tr = dir == 0 ? 16 * i : 16 * i + 15;
                    const bf16* ST = WSP(bf16, WS_HST) + (dir ? sidx_b : sidx_f) * (128 * 128);
                    f32x4 td = (f32x4){0.f, 0.f, 0.f, 0.f};
#pragma unroll 1
                    for (int kk = 0; kk < 4; ++kk) {
                        const int dof = 32 * kk + 8 * fq;
                        const f32x4 bt0 = *(LAS f32x4*)(BB + (16 * i + fr) * 132 + dof), bt1 = *(LAS f32x4*)(BB + (16 * i + fr) * 132 + dof + 4);
                        const f32x4 rf0 = *(LAS f32x4*)(BB + tr * 132 + dof), rf1 = *(LAS f32x4*)(BB + tr * 132 + dof + 4);
                        float q8[8]; unpack8(*(const LAS v4u*)(QL + (16 * i + fr) * PIT + dof * 2), q8);
                        const float bt[8] = {bt0[0], bt0[1], bt0[2], bt0[3], bt1[0], bt1[1], bt1[2], bt1[3]}, rf[8] = {rf0[0], rf0[1], rf0[2], rf0[3], rf1[0], rf1[1], rf1[2], rf1[3]};
                        v4u qh, qe;
                        qh.x = pk2(q8[0] * __expf(bt[0] - rf[0]), q8[1] * __expf(bt[1] - rf[1])); qh.y = pk2(q8[2] * __expf(bt[2] - rf[2]), q8[3] * __expf(bt[3] - rf[3]));
                        qh.z = pk2(q8[4] * __expf(bt[4] - rf[4]), q8[5] * __expf(bt[5] - rf[5])); qh.w = pk2(q8[6] * __expf(bt[6] - rf[6]), q8[7] * __expf(bt[7] - rf[7]));
                        qe.x = pk2(q8[0] * __expf(bt[0]), q8[1] * __expf(bt[1])); qe.y = pk2(q8[2] * __expf(bt[2]), q8[3] * __expf(bt[3]));
                        qe.z = pk2(q8[4] * __expf(bt[4]), q8[5] * __expf(bt[5])); qe.w = pk2(q8[6] * __expf(bt[6]), q8[7] * __expf(bt[7]));
                        const bf16x8 qhf = __builtin_bit_cast(bf16x8, qh), qef = __builtin_bit_cast(bf16x8, qe);
#pragma unroll
                        for (int ei = 0; ei < 8; ++ei) { const bf16x8 bb = *(const bf16x8*)(ST + (size_t)(16 * ei + fr) * 128 + dof); oa[ei] = MFMA(qef, bb, oa[ei]); }
#pragma unroll
                        for (int j = 0; j < 8; ++j) {
                            if (dir == 0 ? (j <= i) : (j >= i)) {
                                const f32x4 bs0 = *(LAS f32x4*)(BB + (16 * j + fr) * 132 + dof), bs1 = *(LAS f32x4*)(BB + (16 * j + fr) * 132 + dof + 4);
                                float k8[8]; unpack8(*(const LAS v4u*)(KL + (16 * j + fr) * PIT + dof * 2), k8);
                                const float bs[8] = {bs0[0], bs0[1], bs0[2], bs0[3], bs1[0], bs1[1], bs1[2], bs1[3]};
                                v4u kh;
                                kh.x = pk2(k8[0] * __expf(fminf(rf[0] - bs[0], 60.f)), k8[1] * __expf(fminf(rf[1] - bs[1], 60.f))); kh.y = pk2(k8[2] * __expf(fminf(rf[2] - bs[2], 60.f)), k8[3] * __expf(fminf(rf[3] - bs[3], 60.f)));
                                kh.z = pk2(k8[4] * __expf(fminf(rf[4] - bs[4], 60.f)), k8[5] * __expf(fminf(rf[5] - bs[5], 60.f))); kh.w = pk2(k8[6] * __expf(fminf(rf[6] - bs[6], 60.f)), k8[7] * __expf(fminf(rf[7] - bs[7], 60.f)));
                                if (j == i) td = MFMA(qhf, __builtin_bit_cast(bf16x8, kh), td); else aa[j] = MFMA(qhf, __builtin_bit_cast(bf16x8, kh), aa[j]);
                            }
                        }
                    }
#pragma unroll
                    for (int r = 0; r < 4; ++r) { const int tl = 4 * fq + r; const bool keep = dir == 0 ? (fr <= tl) : (fr >= tl); td[r] = keep ? td[r] : 0.f; }
#pragma unroll
                    for (int j = 0; j < 8; ++j) if (j == i) aa[j] += td;
                }
                __syncthreads();
            }
#pragma unroll
            for (int j = 0; j < 8; ++j)
#pragma unroll
                for (int r = 0; r < 4; ++r) *(LAS bf16*)(AL + (16 * w + 4 * fq + r) * PIT + (16 * j + fr) * 2) = (bf16)f2bf(aa[j][r]);
            stage_vt128(VT, prow + 4608 + h * 128 + 32 * g, g, s);
            __syncthreads();
#pragma unroll
            for (int kk = 0; kk < 4; ++kk) { const bf16x8 a = ldsfrag(AL, 16 * w + fr, PIT, kk, fq);
#pragma unroll
                for (int ei = 0; ei < 8; ++ei) oa[ei] = MFMA(a, ldsfrag(VT, 16 * ei + fr, PIT, kk, fq), oa[ei]); }
            float rs[4];
#pragma unroll
            for (int r = 0; r < 4; ++r) { float q = 0.f;
#pragma unroll
                for (int ei = 0; ei < 8; ++ei) q += oa[ei][r] * oa[ei][r];
                rs[r] = 1.0f / sqrtf(sum16(q) * (1.0f / 128.0f) + NORM_EPS); }
            __syncthreads();
#pragma unroll
            for (int ei = 0; ei < 8; ++ei)
#pragma unroll
                for (int r = 0; r < 4; ++r) *(LAS bf16*)(lds + 69632 + (16 * w + 4 * fq + r) * PIT + (16 * ei + fr) * 2) = (bf16)f2bf(oa[ei][r] * rs[r]);
            __syncthreads();
            mix_store<128, 0>(lds + 69632, PIT, P + row0 * NP + 5120 + h * 128, C.hgrn_gn + layer * 512 + h * 128, MIX + row0 * D + 1024 + h * 128, tid);
            __syncthreads();
        } else if ((GRPMASK & 4) && grp == 2) {
            LAS unsigned char* QL = lds; LAS unsigned char* KL = lds + 34816; LAS unsigned char* AL = lds + 69632; LAS unsigned char* VT = lds + 104448;
            float bsc = 0.f, bet = 0.f;
            if (tid < 256) { const int dir = tid >> 7; const float* gp = WSP(float, WS_G16) + (row0 + s) * 16; const float* gb = C.mlstm_gate_b + layer * 16;
                bet = gp[4 * dir + h] + gb[4 * dir + h];
                bsc = scan_wave_sum(logsigmoidf_(gp[8 + 4 * dir + h] + gb[8 + 4 * dir + h]), lane, dir != 0); if (lane == (dir ? 0 : 63)) SC[1920 + w] = bsc; }
            for (int idx = tid; idx < 768; idx += NTHR) { const int j = idx >> 8, qk = (idx >> 7) & 1, dd = idx & 127; SC[2304 + idx] = C.mlstm_conv[(size_t)layer * 3072 + j * 1024 + qk * 512 + h * 128 + dd]; }
            __syncthreads();
            float pmx = 0.f;
            if (tid < 256) { const int dir = tid >> 7; if (dir == 0 ? (w == 1) : (w == 2)) bsc += SC[1920 + (w ^ 1)];
                bet -= bsc;
                pmx = scan_wave_max(bet, lane, dir != 0); if (lane == (dir ? 0 : 63)) SC[1928 + w] = pmx; }
            __syncthreads();
            if (tid < 256) { const int dir = tid >> 7; LAS float* Sd = SC + 1024 * dir; if (dir == 0 ? (w == 1) : (w == 2)) pmx = fmaxf(pmx, SC[1928 + (w ^ 1)]);
                const float m = WSP(float, WS_MSM)[(dir ? sidx_b : sidx_f)], mt = bsc + fmaxf(pmx, m);
                Sd[384 + s] = bet; Sd[512 + s] = bsc - mt; Sd[640 + s] = __expf(bsc + m - mt); Sd[768 + s] = __expf(-mt); }
            {
                const int tall = 128 * c + s, seg0 = c < 2 ? 0 : LC, seg1 = c < 2 ? LC : TB;
                const bool hp = tall - 1 >= seg0, hn = tall + 1 < seg1;
#pragma unroll
                for (int qk = 0; qk < 2; ++qk) { const bf16* xp = prow + 5632 + qk * 512 + h * 128 + 32 * g; const LAS float* cw = SC + 2304 + qk * 128 + 32 * g;
#pragma unroll
                    for (int q = 0; q < 4; ++q) { float a8[8], t8[8];
                        unpack8(*(const v4u*)(xp + 8 * q), t8);
#pragma unroll
                        for (int i = 0; i < 8; ++i) a8[i] = t8[i] * cw[256 + 8 * q + i];
                        if (hp) { unpack8(*(const v4u*)(xp - NP + 8 * q), t8);
#pragma unroll
                            for (int i = 0; i < 8; ++i) a8[i] += t8[i] * cw[8 * q + i]; }
                        if (hn) { unpack8(*(const v4u*)(xp + NP + 8 * q), t8);
#pragma unroll
                            for (int i = 0; i < 8; ++i) a8[i] += t8[i] * cw[512 + 8 * q + i]; }
                        const float sc = qk ? 0.08838834764831845f : 1.0f;
                        v4u o4; o4.x = pk2(siluf_(a8[0]) * sc, siluf_(a8[1]) * sc); o4.y = pk2(siluf_(a8[2]) * sc, siluf_(a8[3]) * sc); o4.z = pk2(siluf_(a8[4]) * sc, siluf_(a8[5]) * sc); o4.w = pk2(siluf_(a8[6]) * sc, siluf_(a8[7]) * sc);
                        *(LAS v4u*)((qk ? KL : QL) + s * PIT + (32 * g + 8 * q) * 2) = o4; } }
            }
            stage_vt128(VT, prow + 6656 + h * 128 + 32 * g, g, s);
            __syncthreads();
            bf16x8 qf[4];
#pragma unroll
            for (int kk = 0; kk < 4; ++kk) qf[kk] = ldsfrag(QL, 16 * w + fr, PIT, kk, fq);
            f32x4 sa[8], hs[8];
#pragma unroll
            for (int j = 0; j < 8; ++j) { sa[j] = (f32x4){0.f, 0.f, 0.f, 0.f}; hs[j] = (f32x4){0.f, 0.f, 0.f, 0.f}; }
#pragma unroll
            for (int kk = 0; kk < 4; ++kk)
#pragma unroll
                for (int j = 0; j < 8; ++j) sa[j] = MFMA(qf[kk], ldsfrag(KL, 16 * j + fr, PIT, kk, fq), sa[j]);
#pragma unroll 1
            for (int dir = 0; dir < 2; ++dir) {
                const LAS float* Sd = SC + 1024 * dir;
                float den[4] = {0.f, 0.f, 0.f, 0.f};
#pragma unroll
                for (int j = 0; j < 8; ++j) { const int ss = 16 * j + fr; const float be = Sd[384 + ss];
#pragma unroll
                    for (int r = 0; r < 4; ++r) { const int t = 16 * w + 4 * fq + r; const bool valid = dir == 0 ? (ss <= t) : (ss >= t);
                        const float wgt = valid ? __expf(fminf(Sd[512 + t] + be, 0.f)) : 0.f, a = sa[j][r] * wgt; den[r] += a;
                        *(LAS bf16*)(AL + t * PIT + ss * 2) = (bf16)f2bf(a); } }
#pragma unroll
                for (int r = 0; r < 4; ++r) den[r] = sum16(den[r]);
                f32x4 ia[9];
#pragma unroll
                for (int j = 0; j < 9; ++j) ia[j] = (f32x4){0.f, 0.f, 0.f, 0.f};
                const bf16* ST = WSP(bf16, WS_MST) + (dir ? sidx_b : sidx_f) * (144 * 128) + (size_t)fr * 128 + 8 * fq;
                LDS_WAIT();
#pragma unroll
                for (int kk = 0; kk < 4; ++kk) {
#pragma unroll
                    for (int ei = 0; ei < 9; ++ei) { const bf16x8 bb = *(const bf16x8*)(ST + ei * 2048 + 32 * kk); ia[ei] = MFMA(qf[kk], bb, ia[ei]); }
                    __builtin_amdgcn_sched_barrier(0); }
                float inv[4];
#pragma unroll
                for (int r = 0; r < 4; ++r) { const int t = 16 * w + 4 * fq + r; const float wi = Sd[640 + t];
                    const float qn = __shfl(ia[8][r], lane & 48);
                    const float dt = den[r] + wi * qn; inv[r] = 1.0f / fmaxf(fabsf(dt), Sd[768 + t]);
#pragma unroll
                    for (int ei = 0; ei < 8; ++ei) ia[ei][r] *= wi; }
#pragma unroll
                for (int kk = 0; kk < 4; ++kk) { const bf16x8 a = ldsfrag(AL, 16 * w + fr, PIT, kk, fq);
#pragma unroll
                    for (int ei = 0; ei < 8; ++ei) ia[ei] = MFMA(a, ldsfrag(VT, 16 * ei + fr, PIT, kk, fq), ia[ei]);
                    __builtin_amdgcn_sched_barrier(0); }
#pragma unroll
                for (int r = 0; r < 4; ++r)
#pragma unroll
                    for (int ei = 0; ei < 8; ++ei) hs[ei][r] += ia[ei][r] * inv[r];
                LDS_WAIT();
            }
            float mean[4], rs[4];
#pragma unroll
            for (int r = 0; r < 4; ++r) { float q = 0.f;
#pragma unroll
                for (int ei = 0; ei < 8; ++ei) q += hs[ei][r];
                mean[r] = sum16(q) * (1.0f / 128.0f); float q2 = 0.f;
#pragma unroll
                for (int ei = 0; ei < 8; ++ei) { const float dlt = hs[ei][r] - mean[r]; q2 += dlt * dlt; }
                rs[r] = 1.0f / sqrtf(sum16(q2) * (1.0f / 128.0f) + NORM_EPS); }
            __syncthreads();
#pragma unroll
            for (int ei = 0; ei < 8; ++ei)
#pragma unroll
                for (int r = 0; r < 4; ++r) *(LAS bf16*)(lds + (16 * w + 4 * fq + r) * PIT + (16 * ei + fr) * 2) = (bf16)f2bf((hs[ei][r] - mean[r]) * rs[r]);
            __syncthreads();
            mix_store<128, 1>(lds, PIT, P + row0 * NP + 7168 + h * 128, C.mlstm_gn + layer * 512 + h * 128, MIX + row0 * D + 1536 + h * 128, tid);
            __syncthreads();
        }
    }
}
struct Args { const float* in[23]; float* out; unsigned char* ws; int ph_lo, ph_hi; };
__device__ __forceinline__ void moe_tables(const Ctx& C, LAS int* tab) {
    __syncthreads();
    if (C.tid == 0) { int cnt[8], off[9]; expert_offsets(C, cnt, off);
#pragma unroll
        for (int e = 0; e < 8; ++e) { tab[e] = (off[e + 1] - off[e]) >> 8; tab[8 + e] = off[e] >> 8; tab[16 + e] = off[e] >> 8; }
        tab[24] = off[8] >> 8; }
    __syncthreads();
}
typedef const __attribute__((address_space(4))) Args* KArgs;
__device__ __forceinline__ Ctx make_ctx(unsigned char* lds_raw) {
    KArgs ka = (KArgs)__builtin_amdgcn_kernarg_segment_ptr(); asm volatile("" : "+s"(ka));
    Ctx C;
    C.lds = (LAS unsigned char*)lds_raw;
    C.tid = threadIdx.x; C.lane = C.tid & 63; C.wave = __builtin_amdgcn_readfirstlane(C.tid >> 6); C.G = gridDim.x; C.bx = blockIdx.x;
    C.x = ka->in[0]; C.c = ka->in[1]; C.ctx = ka->in[2]; C.c_ctx = ka->in[3]; C.w_ada = ka->in[4]; C.b_ada = ka->in[5]; C.norm_g = ka->in[6]; C.w_in = ka->in[7]; C.w_out = ka->in[8];
    C.ret_decay = ka->in[9]; C.ret_gn = ka->in[10]; C.hgrn_lb = ka->in[11]; C.hgrn_gn = ka->in[12]; C.mlstm_conv = ka->in[13]; C.mlstm_gate_b = ka->in[14]; C.mlstm_gn = ka->in[15];
    C.w_ffn1 = ka->in[16]; C.w_ffn3 = ka->in[17]; C.w_ffn2 = ka->in[18]; C.w_router = ka->in[19]; C.w_exp1 = ka->in[20]; C.w_exp3 = ka->in[21]; C.w_exp2 = ka->in[22];
    C.out = ka->out; C.ws = ka->ws;
    return C;
}
#ifndef PHMASK
#define PHMASK 0xFFFFF
#endif
#define IN(k) (lo <= (k) && (k) < hi)
#define EN(n) ((PHMASK >> (n)) & 1)
#define SEAM(k) do { if (!MK_PER_PHASE && IN(k) && IN((k) + 1)) xcd_barrier(bar); } while (0)
#define MKCTX() const Ctx C = make_ctx(lds_raw)
#ifndef REPMASK
#define REPMASK 0
#endif
#define REP(n) _Pragma("unroll 1") for (int rep_ = 0; rep_ <= ((REPMASK >> (n)) & 1); ++rep_)
template <int layer> __device__ __forceinline__ void layer_phases(unsigned char* lds_raw, LAS int* TAB, const XcdBarrier& bar, const int lo, const int hi) {
    using namespace pg8;
        const int base = 2 + 9 * layer;
        if (EN(2) && IN(base + 0)) { MKCTX();
            Gemm g{WSP(bf16, WS_H), WSP(bf16, WS_WIN) + (size_t)layer * NP * D, TT, NP, D}; TileOrder S; S.init_static(TT, NP, C.G, C.bx);
            EpiBf16 E{WSP(bf16, WS_P), NP};
            REP(2) gemm_phase<EpiBf16, TileOrder, true, true>(C.lds, g, S, E);
            SEAM(base + 0);
        }
        if (EN(3) && IN(base + 1)) { REP(3) { MKCTX(); phase_state(C, layer); } SEAM(base + 1); }
        if (EN(4) && IN(base + 2)) { REP(4) { MKCTX(); phase_out(C, layer); } SEAM(base + 2); }
        if (EN(5) && IN(base + 3)) { MKCTX();
            Gemm g{WSP(bf16, WS_MIX), WSP(bf16, WS_WOUT) + (size_t)layer * D * D, TT, D, D}; TileOrder S;
            if (layer == 0) S.init_static(TT, D, C.G, C.bx); else S.init_latent(C.G, C.bx);
            EpiF32 E{WSP(float, WS_Y), D};
            REP(5) gemm_phase<EpiF32, TileOrder, true, true>(C.lds, g, S, E);
            SEAM(base + 3);
        }
        if (EN(6) && IN(base + 4)) { MKCTX(); row_phase<1>(C, layer); SEAM(base + 4); }
        if (EN(7) && IN(base + 5)) { MKCTX(); if (layer == 1) phase_gather(C); SEAM(base + 5); }
        if (EN(8) && IN(base + 6)) { MKCTX();
            TileOrder S; Gemm g;
            if (layer == 0) { g = Gemm{WSP(bf16, WS_H), WSP(bf16, WS_WF13), TT, 2 * DFF, D}; S.init_static(TT, 2 * DFF, C.G, C.bx); }
            else { moe_tables(C, TAB); g = Gemm{WSP(bf16, WS_HG), WSP(bf16, WS_WE13), 0, 2 * DFF, D}; S.init_moe(TAB, 44, C.G, C.bx); }
            EpiSwiGLU E{WSP(bf16, WS_U), DFF};
            REP(8) gemm_phase<EpiSwiGLU, TileOrder, true, true>(C.lds, g, S, E);
            SEAM(base + 6);
        }
        if (EN(9) && IN(base + 7)) { MKCTX();
            TileOrder S; Gemm g; EpiF32 E;
            if (layer == 0) { g = Gemm{WSP(bf16, WS_U), WSP(bf16, WS_WF2), TT, D, DFF}; S.init_static(TT, D, C.G, C.bx); E = EpiF32{WSP(float, WS_Y), D}; }
            else { moe_tables(C, TAB); g = Gemm{WSP(bf16, WS_U), WSP(bf16, WS_WE2), 0, D, DFF}; S.init_moe(TAB, 8, C.G, C.bx); E = EpiF32{WSP(float, WS_YS), D}; }
            REP(9) gemm_phase<EpiF32, TileOrder, true, true>(C.lds, g, S, E);
            SEAM(base + 7);
        }
        if (EN(10) && IN(base + 8)) { MKCTX(); if (layer == 0) row_phase<2>(C, 0); else row_phase<3>(C, 1); SEAM(base + 8); }
}
__global__ void __launch_bounds__(NTHR, 2) fwd_kernel(Args args) {
    extern __shared__ __attribute__((aligned(16))) unsigned char lds_raw[];
    volatile LAS unsigned* MISC = (volatile LAS unsigned*)((LAS unsigned char*)lds_raw + MISC_OFF);
    LAS int* TAB = (LAS int*)((LAS unsigned char*)lds_raw + MISC_OFF + 64);
    if (threadIdx.x < 128) MISC[threadIdx.x] = 0u;
    __syncthreads();
    XcdBarrier bar; bar.bar = (unsigned*)(args.ws + WS_CTL) + CW_BAR; bar.x = 0; bar.st = nullptr;
    if (!MK_PER_PHASE) bar = xcd_barrier_post((unsigned*)(args.ws + WS_CTL) + CW_BAR, MISC);
    const int lo = args.ph_lo, hi = args.ph_hi;
    using namespace pg8;
    if (EN(0) && IN(0)) { REP(0) { MKCTX(); phase_prologue(C); } SEAM(0); }
    if (EN(1) && IN(1)) { MKCTX(); row_phase<0>(C, 0); SEAM(1); }
    layer_phases<0>(lds_raw, TAB, bar, lo, hi);
    layer_phases<1>(lds_raw, TAB, bar, lo, hi);
#undef IN
#undef SEAM
}

extern "C" void kernel_launch(void* const* d_in, const int* in_sizes, int n_in, void* d_out, int out_size, void* d_ws, size_t ws_size, hipStream_t stream) {
    static int grid = 0;
    if (grid == 0) {
        if (n_in != 23 || out_size != NB * SEQ * D || ws_size < WS_END) { fprintf(stderr, "kernel_launch: unexpected shapes (n_in %d, out %d, ws %zu < %zu); nothing launched\n", n_in, out_size, ws_size, (size_t)WS_END); grid = -1; return; }
        int dev = 0, cus = 0, per_cu = 0;
        if (hipGetDevice(&dev) != hipSuccess || hipDeviceGetAttribute(&cus, hipDeviceAttributeMultiprocessorCount, dev) != hipSuccess) { grid = -1; return; }
        if (hipFuncSetAttribute((const void*)fwd_kernel, hipFuncAttributeMaxDynamicSharedMemorySize, LDS_BYTES) != hipSuccess) { fprintf(stderr, "kernel_launch: hipFuncSetAttribute failed\n"); grid = -1; return; }
        if (hipOccupancyMaxActiveBlocksPerMultiprocessor(&per_cu, (const void*)fwd_kernel, NTHR, LDS_BYTES) != hipSuccess || per_cu < 1) fprintf(stderr, "kernel_launch: occupancy query reports %d\n", per_cu);
        (void)hipGetLastError();
        grid = cus;
    }
    if (grid < 0) return;
    (void)hipMemsetAsync((char*)d_ws + WS_CTL, 0, CTL_ZERO_BYTES, stream);
    Args a{};
    for (int i = 0; i < 23; ++i) a.in[i] = (const float*)d_in[i];
    a.out = (float*)d_out; a.ws = (unsigned char*)d_ws;
#if MK_PER_PHASE
    for (int p = 0; p < N_PHASES; ++p) { if (p == 7) continue; a.ph_lo = p; a.ph_hi = p + 1; hipLaunchKernelGGL(fwd_kernel, dim3(grid), dim3(NTHR), LDS_BYTES, stream, a); }
#else
    a.ph_lo = 0; a.ph_hi = N_PHASES; hipLaunchKernelGGL(fwd_kernel, dim3(grid), dim3(NTHR), LDS_BYTES, stream, a);
#endif
}
```

```cpp
#include <hip/hip_runtime.h>
#include <cstdio>
#include <cstdint>
namespace pg8 {
#define PG8_LAS __attribute__((address_space(3)))
typedef unsigned short bf16_t;
typedef short bf16x8 __attribute__((ext_vector_type(8)));
typedef float f32x4 __attribute__((ext_vector_type(4)));
typedef unsigned u32x4 __attribute__((ext_vector_type(4)));
constexpr int BM = 256, BK = 64, HALF = 128, HTB = HALF * BK * 2  , STAGE_BYTES = 8 * HTB, NXCD = 8, WGM = 8;

__host__ __device__ __forceinline__ int lds_byte(int r, int c) { const int st = (r >> 4) * 2 + (c >> 5), rr = r & 15, cc = c & 31, ob = rr * 64 + cc * 2; return st * 1024 + (ob ^ (((ob >> 9) & 1) << 5)); }
__host__ __device__ __forceinline__ void stage_rc(int b, int& R, int& C) { const int st = b / 1024, sb = b % 1024, swz = sb ^ (((sb >> 9) & 1) << 5); R = (st >> 1) * 16 + swz / 64; C = (st & 1) * 32 + (swz % 64) / 2; }
__host__ __device__ __forceinline__ int perm32(int rho) { const int n = rho >> 4, i = rho & 15; return 8 * (i >> 2) + 4 * n + (i & 3); }


struct Unit { int pm, pn, po; };
struct Gemm { const bf16_t* A; const bf16_t* Bt; int M, N, K; };
__device__ __forceinline__ unsigned cvt_pk_bf16(float lo, float hi) { unsigned r; asm volatile("v_cvt_pk_bf16_f32 %0, %1, %2" : "=v"(r) : "v"(lo), "v"(hi)); return r; }

struct TileOrder {
    int mode, nM, nN, nwg, G, c, NT; const PG8_LAS int* tab;
    __device__ __forceinline__ void init_static(int M, int N, int G_, int c_) { mode = 0; nM = M / BM; nN = N / BM; nwg = nM * nN; G = G_; c = c_; NT = 0; tab = nullptr; }
    __device__ __forceinline__ void init_latent(int G_, int c_) { mode = 1; nM = 32; nN = 8; nwg = 256; G = G_; c = c_; NT = 0; tab = nullptr; }
    __device__ __forceinline__ void init_moe(const PG8_LAS int* tab_, int NT_, int G_, int c_) { mode = 2; tab = tab_; NT = NT_; nM = 0; nN = NT_; nwg = tab_[24] * NT_; G = G_; c = c_; }
    __device__ __forceinline__ bool next(int i, Unit& u) const {
        const long L = (long)i * G + c; if (L >= nwg) return false;
        if (mode == 0) {
            int wgid = (int)L; { const int q = nwg / NXCD, r = nwg % NXCD, xcd = wgid % NXCD, off = wgid / NXCD; wgid = (xcd < r ? xcd * (q + 1) : r * (q + 1) + (xcd - r) * q) + off; }
            const int nig = WGM * nN, gid = wgid / nig, fm = gid * WGM, gsz = (nM - fm) < WGM ? (nM - fm) : WGM;
            u.pm = fm + ((wgid % nig) % gsz); u.pn = (wgid % nig) / gsz; u.po = u.pn; return true;
        } else if (mode == 1) {
            const int l = (int)L, idx = l & 31; u.pn = l >> 5; u.po = u.pn; u.pm = 9 * (idx >> 3) + 1 + (idx & 7); return true;
        } else {
            u.pm = tab[32 + 4 * i]; u.pn = tab[33 + 4 * i]; u.po = tab[34 + 4 * i]; return true;
        }
    }
    __device__ __forceinline__ void a_ready(const Unit&) const {}
    __device__ __forceinline__ void done(const Unit&) const {}
};

struct EpiF32 {
    static constexpr bool PERM = false, AFTER_DRAIN = false, FP8 = false;
    float* C; int ldc;
    __device__ __forceinline__ void operator()(const f32x4 (&acc)[2][2][4][2], const Unit& u, int wr, int wc, int fr, int fq) const {
        const int row0 = u.pm * BM + wr * 64 + fr, col0 = u.po * BM + wc * 32 + 4 * fq;
#pragma unroll
        for (int ai = 0; ai < 2; ++ai)
#pragma unroll
            for (int m = 0; m < 4; ++m) { float* rowp = C + (size_t)(row0 + ai * HALF + m * 16) * ldc + col0;
#pragma unroll
                for (int bj = 0; bj < 2; ++bj)
#pragma unroll
                    for (int n = 0; n < 2; ++n) *(f32x4*)(rowp + bj * HALF + n * 16) = acc[ai][bj][m][n]; }
    }
};
struct EpiProj {
    static constexpr bool PERM = true, AFTER_DRAIN = false, FP8 = false;
    bf16_t* O; int ldc; float* LF; const float* hgrn_lb; int layer;
    __device__ __forceinline__ void operator()(const f32x4 (&acc)[2][2][4][2], const Unit& u, int wr, int wc, int fr, int fq) const {
        const int row0 = u.pm * BM + wr * 64 + fr, col0 = u.po * BM + wc * 32 + 8 * fq, po = u.po;
        const int mode = (po >= 14 && po < 18) ? 3 : ((po >= 28) ? 2 : (((po >= 8 && po < 14) || po == 20 || po == 21) ? 1 : 0));
        float lb[2][8];
        if (mode == 3) {
#pragma unroll
            for (int bj = 0; bj < 2; ++bj)
#pragma unroll
                for (int j = 0; j < 8; ++j) { const int ch = (col0 + bj * HALF + j - 3584) & 511; lb[bj][j] = layer == 0 ? 0.0f : __builtin_amdgcn_rcpf(1.0f + __expf(hgrn_lb[ch] - hgrn_lb[512 + ch])); }
        }
#pragma unroll
        for (int ai = 0; ai < 2; ++ai)
#pragma unroll
            for (int m = 0; m < 4; ++m) { const size_t row = (size_t)(row0 + ai * HALF + m * 16); bf16_t* rowp = O + row * ldc + col0;
#pragma unroll
                for (int bj = 0; bj < 2; ++bj) { float v[8];
#pragma unroll
                    for (int j = 0; j < 4; ++j) { v[j] = acc[ai][bj][m][0][j]; v[4 + j] = acc[ai][bj][m][1][j]; }
                    if (mode == 1) {
#pragma unroll
                        for (int j = 0; j < 8; ++j) v[j] = v[j] * __builtin_amdgcn_rcpf(1.0f + __expf(-v[j]));
                    } else if (mode == 2) {
#pragma unroll
                        for (int j = 0; j < 8; ++j) v[j] = __builtin_amdgcn_rcpf(1.0f + __expf(-v[j]));
                    } else if (mode == 3) {
                        float lf[8];
#pragma unroll
                        for (int j = 0; j < 8; ++j) { const float x = v[j], ex = __expf(-fabsf(x)), r = __builtin_amdgcn_rcpf(1.0f + ex), sg = x >= 0.f ? r : ex * r, sgm = x >= 0.f ? ex * r : r;
                            lf[j] = __logf(lb[bj][j] + (1.0f - lb[bj][j]) * sg); v[j] = (1.0f - lb[bj][j]) * sgm; }
                        float* lp = LF + row * 1024 + (col0 + bj * HALF - 3584);
                        *(f32x4*)lp = (f32x4){lf[0], lf[1], lf[2], lf[3]}; *(f32x4*)(lp + 4) = (f32x4){lf[4], lf[5], lf[6], lf[7]};
                    }
                    u32x4 w; w.x = cvt_pk_bf16(v[0], v[1]); w.y = cvt_pk_bf16(v[2], v[3]); w.z = cvt_pk_bf16(v[4], v[5]); w.w = cvt_pk_bf16(v[6], v[7]);
                    *(u32x4*)(rowp + bj * HALF) = w; } }
    }
};
struct EpiSwiGLU {
    static constexpr bool PERM = true, AFTER_DRAIN = false, FP8 = false;
    bf16_t* O; int ldc;
    __device__ __forceinline__ void operator()(const f32x4 (&acc)[2][2][4][2], const Unit& u, int wr, int wc, int fr, int fq) const {
        const int row0 = u.pm * BM + wr * 64 + fr, col0 = u.po * HALF + wc * 32 + 8 * fq;
#pragma unroll
        for (int ai = 0; ai < 2; ++ai)
#pragma unroll
            for (int m = 0; m < 4; ++m) { bf16_t* rowp = O + (size_t)(row0 + ai * HALF + m * 16) * ldc + col0;
                float o[8];
#pragma unroll
                for (int n = 0; n < 2; ++n)
#pragma unroll
                    for (int j = 0; j < 4; ++j) { const float a = acc[ai][0][m][n][j], b = acc[ai][1][m][n][j]; o[4 * n + j] = a * __builtin_amdgcn_rcpf(1.0f + __expf(-a)) * b; }
                u32x4 w; w.x = cvt_pk_bf16(o[0], o[1]); w.y = cvt_pk_bf16(o[2], o[3]); w.z = cvt_pk_bf16(o[4], o[5]); w.w = cvt_pk_bf16(o[6], o[7]);
                *(u32x4*)rowp = w; }
    }
};

typedef int pg8_v4i __attribute__((ext_vector_type(4)));
typedef int pg8_v8i __attribute__((ext_vector_type(8)));
__device__ __forceinline__ bf16x8 pg8_lo(const pg8_v8i v) { return __builtin_bit_cast(bf16x8, (pg8_v4i)__builtin_shufflevector(v, v, 0, 1, 2, 3)); }
__device__ __forceinline__ bf16x8 pg8_hi(const pg8_v8i v) { return __builtin_bit_cast(bf16x8, (pg8_v4i)__builtin_shufflevector(v, v, 4, 5, 6, 7)); }
__device__ __forceinline__ pg8_v8i pg8_cat(const bf16x8 lo, const bf16x8 hi) { const pg8_v4i a = __builtin_bit_cast(pg8_v4i, lo), b = __builtin_bit_cast(pg8_v4i, hi); return __builtin_shufflevector(a, b, 0, 1, 2, 3, 4, 5, 6, 7); }
__device__ __forceinline__ unsigned pk4_fp8(float a, float b, float c, float d) {
    a = __builtin_fminf(__builtin_fmaxf(a, -448.f), 448.f); b = __builtin_fminf(__builtin_fmaxf(b, -448.f), 448.f); c = __builtin_fminf(__builtin_fmaxf(c, -448.f), 448.f); d = __builtin_fminf(__builtin_fmaxf(d, -448.f), 448.f);
    int w = 0; w = __builtin_amdgcn_cvt_pk_fp8_f32(a, b, w, false); w = __builtin_amdgcn_cvt_pk_fp8_f32(c, d, w, true); return (unsigned)w; }
struct EpiF32F8 {
    static constexpr bool PERM = false, AFTER_DRAIN = false, FP8 = true;
    float* C; int ldc; int scale_w, scale_x;
    __device__ __forceinline__ void operator()(const f32x4 (&acc)[2][2][4][2], const Unit& u, int wr, int wc, int fr, int fq) const {
        const int row0 = u.pm * BM + wr * 64 + fr, col0 = u.po * BM + wc * 32 + 4 * fq;
#pragma unroll
        for (int ai = 0; ai < 2; ++ai)
#pragma unroll
            for (int m = 0; m < 4; ++m) { float* rowp = C + (size_t)(row0 + ai * HALF + m * 16) * ldc + col0;
#pragma unroll
                for (int bj = 0; bj < 2; ++bj)
#pragma unroll
                    for (int n = 0; n < 2; ++n) *(f32x4*)(rowp + bj * HALF + n * 16) = acc[ai][bj][m][n]; }
    }
};
struct EpiSwiGLUF8 {
    static constexpr bool PERM = true, AFTER_DRAIN = false, FP8 = true;
    int scale_w, scale_x; unsigned char* O; int ldc; float out_scale;
    __device__ __forceinline__ void operator()(const f32x4 (&acc)[2][2][4][2], const Unit& u, int wr, int wc, int fr, int fq) const {
        const int row0 = u.pm * BM + wr * 64 + fr, col0 = u.po * HALF + wc * 32 + 8 * fq;
#pragma unroll
        for (int ai = 0; ai < 2; ++ai)
#pragma unroll
            for (int m = 0; m < 4; ++m) { unsigned char* rowp = O + (size_t)(row0 + ai * HALF + m * 16) * ldc + col0;
                float o[8];
#pragma unroll
                for (int n = 0; n < 2; ++n)
#pragma unroll
                    for (int j = 0; j < 4; ++j) { const float a = acc[ai][0][m][n][j], b = acc[ai][1][m][n][j]; o[4 * n + j] = a * __builtin_amdgcn_rcpf(1.0f + __expf(-a)) * b * out_scale; }
                typedef unsigned u32x2 __attribute__((ext_vector_type(2)));
                u32x2 w; w.x = pk4_fp8(o[0], o[1], o[2], o[3]); w.y = pk4_fp8(o[4], o[5], o[6], o[7]);
                *(u32x2*)rowp = w; }
    }
};
template <class Epi, class Sched, bool ALIGN_EPI = false, bool SP2 = false>
__device__ __forceinline__ void gemm_phase(PG8_LAS unsigned char* lds, const Gemm g, const Sched& S, const Epi& E) {
    int tid0 = threadIdx.x; asm volatile("" : "+v"(tid0));
    const int tid = tid0, wid = __builtin_amdgcn_readfirstlane(tid >> 6), lane = tid & 63, wr = wid >> 2, wc = wid & 3, fr = lane & 15, fq = lane >> 4;
    const int K = g.K, nt = K / BK;
    unsigned voffA[2], voffB[2];
#pragma unroll
    for (int i = 0; i < 2; ++i) { int R, C; stage_rc(tid * 16 + i * 8192, R, C); const int Rb = Epi::PERM ? ((R & ~31) + perm32(R & 31)) : R;
        voffA[i] = (unsigned)(R * K + C) * 2u; voffB[i] = (unsigned)(Rb * K + C) * 2u; }
    const size_t kstep = (size_t)(BK * 2);
    const size_t hstep = (size_t)HALF * K * 2;
    const size_t tstep = 2 * hstep;
    const unsigned ldsw = (unsigned)wid * 1024u;
    const int aoff = lds_byte(wr * 64 + fr, fq * (Epi::FP8 ? 16 : 8)), boff = lds_byte(wc * 32 + fr, fq * (Epi::FP8 ? 16 : 8));
#define PG8_SA(b, h) (((b) * 2 + (h)) * HTB)
#define PG8_SB(b, h) ((4 + (b) * 2 + (h)) * HTB)
#define PG8_STAGE(bufoff, gbase, voff) do { _Pragma("unroll") for (int _i = 0; _i < 2; ++_i) \
        __builtin_amdgcn_global_load_lds((const unsigned*)((const char*)(gbase) + (voff)[_i]), (PG8_LAS unsigned*)(lds + (bufoff) + ldsw + _i * 8192), 16, 0, 0); } while (0)
#define PG8_LDA(dst, b, h) do { _Pragma("unroll") for (int m = 0; m < 4; ++m) { const PG8_LAS unsigned char* p_ = lds + PG8_SA(b, h) + aoff + m * 2048; \
        if constexpr (Epi::FP8) dst[m] = *(const PG8_LAS pg8_v8i*)p_; else dst[m] = pg8_cat(*(const PG8_LAS bf16x8*)p_, *(const PG8_LAS bf16x8*)(p_ + 1024)); } } while (0)
#define PG8_LDB(dst, b, h) do { _Pragma("unroll") for (int n = 0; n < 2; ++n) { const PG8_LAS unsigned char* p_ = lds + PG8_SB(b, h) + boff + n * 2048; \
        if constexpr (Epi::FP8) dst[n] = *(const PG8_LAS pg8_v8i*)p_; else dst[n] = pg8_cat(*(const PG8_LAS bf16x8*)p_, *(const PG8_LAS bf16x8*)(p_ + 1024)); } } while (0)
#define PG8_MMA(ai, bj, At, Bt) do { __builtin_amdgcn_s_setprio(1); _Pragma("unroll") for (int m = 0; m < 4; ++m) _Pragma("unroll") for (int n = 0; n < 2; ++n) { \
        if constexpr (Epi::FP8) { asm volatile("v_mfma_scale_f32_16x16x128_f8f6f4 %0, %1, %2, %0, %3, %4 op_sel_hi:[0,0,0]" : "+v"(acc[ai][bj][m][n]) : "v"(Bt[n]), "v"(At[m]), "v"(sc_w), "v"(sc_x)); } \
        else { acc[ai][bj][m][n] = __builtin_amdgcn_mfma_f32_16x16x32_bf16(pg8_lo(Bt[n]), pg8_lo(At[m]), acc[ai][bj][m][n], 0, 0, 0); \
               acc[ai][bj][m][n] = __builtin_amdgcn_mfma_f32_16x16x32_bf16(pg8_hi(Bt[n]), pg8_hi(At[m]), acc[ai][bj][m][n], 0, 0, 0); } } \
        __builtin_amdgcn_s_setprio(0); } while (0)
#define PG8_WAIT_V(n) asm volatile("s_waitcnt vmcnt(" #n ")" ::: "memory")
#define PG8_WAIT_L(n) asm volatile("s_waitcnt lgkmcnt(" #n ")" ::: "memory")
#define PG8_BAR __builtin_amdgcn_s_barrier()
#define PG8_SCHED __builtin_amdgcn_sched_barrier(0)
    int sc_w = 0, sc_x = 0; if constexpr (Epi::FP8) { sc_w = E.scale_w; sc_x = E.scale_x; }
    Unit cur, nxt; int ui = 0;
    if (!S.next(0, cur)) return;
    f32x4 acc[2][2][4][2];
#pragma unroll
    for (int a = 0; a < 2; ++a)
#pragma unroll
        for (int b = 0; b < 2; ++b)
#pragma unroll
            for (int m = 0; m < 4; ++m)
#pragma unroll
                for (int n = 0; n < 2; ++n) acc[a][b][m][n] = (f32x4){0.f, 0.f, 0.f, 0.f};
    pg8_v8i At[4], B0[2], B1[2];
    const char* cA = (const char*)g.A + (size_t)cur.pm * tstep; const char* cB = (const char*)g.Bt + (size_t)cur.pn * tstep;
    S.a_ready(cur);
    if constexpr (SP2) {
        PG8_STAGE(PG8_SB(0, 0), cB, voffB); PG8_STAGE(PG8_SB(0, 1), cB + hstep, voffB); PG8_STAGE(PG8_SA(0, 0), cA, voffA); PG8_STAGE(PG8_SA(0, 1), cA + hstep, voffA);
        if (wr == 1) PG8_BAR;
        PG8_WAIT_V(2); PG8_BAR;
        PG8_STAGE(PG8_SB(1, 0), cB + kstep, voffB); PG8_STAGE(PG8_SA(1, 0), cA + kstep, voffA); PG8_STAGE(PG8_SB(1, 1), cB + hstep + kstep, voffB);
        PG8_WAIT_V(6); PG8_BAR;
    } else {
        PG8_STAGE(PG8_SB(0, 0), cB, voffB); PG8_STAGE(PG8_SA(0, 0), cA, voffA); PG8_STAGE(PG8_SB(0, 1), cB + hstep, voffB); PG8_STAGE(PG8_SA(0, 1), cA + hstep, voffA);
        if (wr == 1) PG8_BAR;
        PG8_WAIT_V(4); PG8_BAR;
        PG8_STAGE(PG8_SB(1, 0), cB + kstep, voffB); PG8_STAGE(PG8_SA(1, 0), cA + kstep, voffA); PG8_STAGE(PG8_SB(1, 1), cB + hstep + kstep, voffB);
        PG8_WAIT_V(6); PG8_BAR;
    }
    for (;;) {
        const bool has_next = S.next(ui + 1, nxt);
        const char* nA = has_next ? (const char*)g.A + (size_t)nxt.pm * tstep : cA; const char* nB = has_next ? (const char*)g.Bt + (size_t)nxt.pn * tstep : cB;
        for (int t = 0; t < nt; t += 2) {
            const bool last = (t == nt - 2);
            const char* a1 = cA + (size_t)(t + 1) * kstep;
            const char* a2 = last ? nA : cA + (size_t)(t + 2) * kstep; const char* b2 = last ? nB : cB + (size_t)(t + 2) * kstep;
            const char* a3 = a2 + kstep; const char* b3 = b2 + kstep;
            if (last && has_next) S.a_ready(nxt);
            if constexpr (SP2) {
            PG8_LDB(B0, 0, 0); PG8_LDB(B1, 0, 1); PG8_SCHED; PG8_LDA(At, 0, 0); PG8_STAGE(PG8_SA(1, 1), a1 + hstep, voffA);
            PG8_WAIT_V(8); PG8_WAIT_L(0); PG8_BAR; PG8_MMA(0, 0, At, B0); PG8_MMA(0, 1, At, B1); PG8_BAR; PG8_SCHED;
            PG8_LDA(At, 0, 1); PG8_STAGE(PG8_SB(0, 0), b2, voffB); PG8_STAGE(PG8_SB(0, 1), b2 + hstep, voffB); PG8_STAGE(PG8_SA(0, 0), a2, voffA);
            PG8_WAIT_V(8); PG8_WAIT_L(0); PG8_BAR; PG8_MMA(1, 0, At, B0); PG8_MMA(1, 1, At, B1); PG8_BAR; PG8_SCHED;
            PG8_LDB(B0, 1, 0); PG8_LDB(B1, 1, 1); PG8_SCHED; PG8_LDA(At, 1, 0); PG8_STAGE(PG8_SA(0, 1), a2 + hstep, voffA);
            PG8_WAIT_V(8); PG8_WAIT_L(0); PG8_BAR; PG8_MMA(0, 0, At, B0); PG8_MMA(0, 1, At, B1); PG8_BAR; PG8_SCHED;
            PG8_LDA(At, 1, 1); PG8_STAGE(PG8_SB(1, 0), b3, voffB); PG8_STAGE(PG8_SB(1, 1), b3 + hstep, voffB); PG8_STAGE(PG8_SA(1, 0), a3, voffA);
            PG8_WAIT_V(8); PG8_WAIT_L(0); PG8_BAR; PG8_MMA(1, 0, At, B0); PG8_MMA(1, 1, At, B1); PG8_BAR; PG8_SCHED;
            } else {
            PG8_LDB(B0, 0, 0); PG8_SCHED; PG8_LDA(At, 0, 0); PG8_STAGE(PG8_SA(1, 1), a1 + hstep, voffA);
            PG8_WAIT_L(8); PG8_BAR; PG8_WAIT_L(0); PG8_MMA(0, 0, At, B0); PG8_BAR; PG8_SCHED;
            PG8_LDB(B1, 0, 1); PG8_STAGE(PG8_SB(0, 0), b2, voffB);
            PG8_BAR; PG8_WAIT_L(0); PG8_MMA(0, 1, At, B1); PG8_BAR;
            PG8_LDA(At, 0, 1); PG8_STAGE(PG8_SA(0, 0), a2, voffA);
            PG8_BAR; PG8_WAIT_L(0); PG8_MMA(1, 0, At, B0); PG8_BAR; PG8_SCHED;
            PG8_STAGE(PG8_SB(0, 1), b2 + hstep, voffB);
            PG8_WAIT_V(6); PG8_BAR; PG8_MMA(1, 1, At, B1); PG8_BAR;
            PG8_LDB(B0, 1, 0); PG8_SCHED; PG8_LDA(At, 1, 0); PG8_STAGE(PG8_SA(0, 1), a2 + hstep, voffA);
            PG8_WAIT_L(8); PG8_BAR; PG8_WAIT_L(0); PG8_MMA(0, 0, At, B0); PG8_BAR; PG8_SCHED;
            PG8_LDB(B1, 1, 1); PG8_STAGE(PG8_SB(1, 0), b3, voffB);
            PG8_BAR; PG8_WAIT_L(0); PG8_MMA(0, 1, At, B1); PG8_BAR;
            PG8_LDA(At, 1, 1); PG8_STAGE(PG8_SA(1, 0), a3, voffA);
            PG8_BAR; PG8_WAIT_L(0); PG8_MMA(1, 0, At, B0); PG8_BAR; PG8_SCHED;
            PG8_STAGE(PG8_SB(1, 1), b3 + hstep, voffB);
            PG8_WAIT_V(6); PG8_BAR; PG8_MMA(1, 1, At, B1); PG8_BAR;
            }
        }
        if constexpr (Epi::FP8) asm volatile("s_nop 15\n\ts_nop 15" ::: "memory");
        if constexpr (ALIGN_EPI) { if (wr == 0) PG8_BAR; }
        if constexpr (!Epi::AFTER_DRAIN) { E(acc, cur, wr, wc, fr, fq); S.done(cur); }
        if (!has_next) break;
#pragma unroll
        for (int a = 0; a < 2; ++a)
#pragma unroll
            for (int b = 0; b < 2; ++b)
#pragma unroll
                for (int m = 0; m < 4; ++m)
#pragma unroll
                    for (int n = 0; n < 2; ++n) acc[a][b][m][n] = (f32x4){0.f, 0.f, 0.f, 0.f};
        cur = nxt; cA = nA; cB = nB; ++ui;
        if constexpr (ALIGN_EPI) { if (wr == 1) PG8_BAR; }
    }
    PG8_WAIT_V(0);
    if constexpr (!ALIGN_EPI) { if (wr == 0) PG8_BAR; }
    PG8_BAR;
    if constexpr (Epi::AFTER_DRAIN) { E.fused(acc, cur, wr, wc, fr, fq, lds, wid, lane); S.done(cur); }
#undef PG8_SA
#undef PG8_SB
#undef PG8_STAGE
#undef PG8_LDA
#undef PG8_LDB
#undef PG8_MMA
#undef PG8_WAIT_V
#undef PG8_WAIT_L
#undef PG8_BAR
#undef PG8_SCHED
}
}

constexpr int D = 2048, NB = 4, SEQ = 2048, LC = 256, TB = LC + SEQ  , TT = NB * TB  ;
constexpr int NP = 7680  , NPW = 7696  , DFF = 5632, NE = 8, NCH = 18  ;
constexpr float NORM_EPS = 1e-6f;
constexpr float W13_SCALE = 128.f, W2_SCALE = 256.f, X8_SCALE = 8.f, U8_SCALE = 8.f;
constexpr int SB_W13 = 0x78787878  , SB_W2 = 0x77777777  , SB_X8 = 0x7c7c7c7c  ;
constexpr int NWAVES = 8, NTHR = 512;
#ifndef MK_PER_PHASE
#define MK_PER_PHASE 0
#endif
constexpr int N_PHASES = 20;
constexpr size_t MiB = 1u << 20;
constexpr size_t WS_CTL = 0, CTL_ZERO_BYTES = 64 * 1024;
constexpr size_t WS_G16 = 1 * MiB;
constexpr size_t WS_LIST = 2 * MiB;
constexpr size_t WS_TOKINFO = 3 * MiB;
constexpr size_t WS_MODP = 4 * MiB;
constexpr size_t WS_MSM = 12 * MiB;
constexpr size_t WS_WIN = 16 * MiB;
constexpr size_t WS_WOUT = 76 * MiB;
constexpr size_t WS_WF13 = 92 * MiB;
constexpr size_t WS_WF2 = 136 * MiB;
constexpr size_t WS_WE13 = 158 * MiB;
constexpr size_t WS_WE2 = 510 * MiB;
constexpr size_t WS_X = 686 * MiB;
constexpr size_t WS_H = 758 * MiB;
constexpr size_t WS_Y = 794 * MiB;
constexpr size_t WS_P = 866 * MiB;
constexpr size_t WS_RST = 1001 * MiB;
constexpr size_t WS_HST = 1037 * MiB;
constexpr size_t WS_MST = 1055 * MiB;
constexpr size_t WS_MIX = 1077 * MiB;
constexpr size_t WS_U = 866 * MiB;
constexpr size_t WS_HG = 1113 * MiB;
constexpr size_t WS_YS = 1185 * MiB;
constexpr size_t WS_LF = 1329 * MiB;
constexpr size_t WS_END = 1365 * MiB;
static_assert(WS_U + (size_t)18432 * DFF * 2 <= WS_HG, "U overlay");
constexpr int CW_BAR = 1024, CW_CNT = 8192;
constexpr int LDS_BYTES = 163840, MISC_OFF = LDS_BYTES - 512;

#define GAS __attribute__((address_space(1)))
#define LAS __attribute__((address_space(3)))
typedef unsigned short bf16;
typedef unsigned v4u __attribute__((ext_vector_type(4)));
typedef unsigned v2u __attribute__((ext_vector_type(2)));
typedef float f32x4 __attribute__((ext_vector_type(4)));
typedef short bf16x8 __attribute__((ext_vector_type(8)));
#define LDS_WAIT() asm volatile("s_waitcnt lgkmcnt(0)" ::: "memory")
#define VM_WAIT() asm volatile("s_waitcnt vmcnt(0)" ::: "memory")
#define LBAR() do { asm volatile("s_waitcnt lgkmcnt(0)" ::: "memory"); __builtin_amdgcn_s_barrier(); asm volatile("" ::: "memory"); } while (0)
__device__ __forceinline__ unsigned pk2(float lo, float hi) { unsigned r; asm("v_cvt_pk_bf16_f32 %0, %1, %2" : "=v"(r) : "v"(lo), "v"(hi)); return r; }
__device__ __forceinline__ unsigned f2bf(float f) { return pk2(f, 0.0f) & 0xffffu; }
__device__ __forceinline__ float bf2f(unsigned b) { return __builtin_bit_cast(float, b << 16); }
__device__ __forceinline__ float bflo(unsigned w) { return __builtin_bit_cast(float, w << 16); }
__device__ __forceinline__ float bfhi(unsigned w) { return __builtin_bit_cast(float, w & 0xffff0000u); }
__device__ __forceinline__ float wave_sum(float v) {
#pragma unroll
    for (int o = 1; o < 64; o <<= 1) v += __shfl_xor(v, o);
    return v;
}
__device__ __forceinline__ float wave_max(float v) {
#pragma unroll
    for (int o = 1; o < 64; o <<= 1) v = fmaxf(v, __shfl_xor(v, o));
    return v;
}
__device__ __forceinline__ float sum16(float v) { v += __shfl_xor(v, 1); v += __shfl_xor(v, 2); v += __shfl_xor(v, 4); v += __shfl_xor(v, 8); return v; }
__device__ __forceinline__ float sigmoidf_(float x) { return __builtin_amdgcn_rcpf(1.0f + __expf(-x)); }
__device__ __forceinline__ float siluf_(float x) { return x * __builtin_amdgcn_rcpf(1.0f + __expf(-x)); }
__device__ __forceinline__ float logsigmoidf_(float x) { return fminf(x, 0.0f) - log1pf(__expf(-fabsf(x))); }
__device__ __forceinline__ bf16x8 ldsfrag(const LAS unsigned char* base, int row, int pitch, int kk, int fq) { return *(const LAS bf16x8*)(base + row * pitch + kk * 64 + fq * 16); }
#define MFMA(a, b, c) __builtin_amdgcn_mfma_f32_16x16x32_bf16((a), (b), (c), 0, 0, 0)
constexpr int PIT = 272;

#define XB_TMO      128
#define XB_XCNT(j)  (256  + 64 * (j))
#define XB_XSUB(j)  (1280 + 64 * (j))
#define XB_XGEN(j)  (2304 + 64 * (j))
#define XB_TOP      3328
#define XB_TOPGEN   3392
#define XCD_BAR_WORDS 3456
#define XB_SPIN_CAP (1u << 18)
__device__ __forceinline__ unsigned xb_ld(unsigned* p)              { return __hip_atomic_load(p, __ATOMIC_RELAXED, __HIP_MEMORY_SCOPE_AGENT); }
__device__ __forceinline__ unsigned xb_add(unsigned* p, unsigned v) { return __hip_atomic_fetch_add(p, v, __ATOMIC_RELAXED, __HIP_MEMORY_SCOPE_AGENT); }
__device__ __forceinline__ unsigned xb_xcc_id() { return (unsigned)__builtin_amdgcn_s_getreg((3 << 11) | 20) & 0xFu; }
#define XB_SPIN(cond, bar) do { unsigned _sp = 0; while (cond) { __builtin_amdgcn_s_sleep(1); \
    if ((++_sp & 255u) == 0u) { if (xb_ld(&(bar)[XB_TMO])) break; if (_sp > XB_SPIN_CAP) { atomicAdd(&(bar)[XB_TMO], 1u); break; } } } } while (0)
struct XcdBarrier { unsigned* bar; unsigned x; volatile LAS unsigned* st; };
__device__ __forceinline__ XcdBarrier xcd_barrier_post(unsigned* bar, volatile LAS unsigned* st) {
    XcdBarrier b; b.bar = bar; b.x = xb_xcc_id(); b.st = st;
    if (threadIdx.x == 0) (void)xb_add(&bar[XB_XCNT(b.x)], 1u);
    return b;
}
__device__ __forceinline__ void xcd_barrier_complete(unsigned* bar, unsigned x, unsigned& nloc, unsigned& nx) {
    const unsigned G = gridDim.x * gridDim.y * gridDim.z;
    unsigned sum, cnt, mine, sp = 0u;
    for (;;) {
        sum = 0u; cnt = 0u; mine = 0u;
#pragma unroll
        for (unsigned j = 0; j < 16; ++j) { const unsigned c = xb_ld(&bar[XB_XCNT(j)]); sum += c; cnt += (c > 0u) ? 1u : 0u; mine = (j == x) ? c : mine; }
        if (sum == G) break;
        __builtin_amdgcn_s_sleep(1);
        if ((++sp & 255u) == 0u) { if (xb_ld(&bar[XB_TMO])) break; if (sp > XB_SPIN_CAP) { atomicAdd(&bar[XB_TMO], 1u); break; } }
    }
    nloc = mine > 0u ? mine : 1u; nx = cnt > 0u ? cnt : 1u;
}
__device__ __forceinline__ void xcd_barrier(const XcdBarrier& b) {
    asm volatile("s_waitcnt vmcnt(0)" ::: "memory");
    __syncthreads();
    if (threadIdx.x == 0) {
        unsigned* bar = b.bar;
        __builtin_amdgcn_s_waitcnt(0);
        unsigned nloc = b.st[0], nx = b.st[1];
        if (nloc == 0u) { xcd_barrier_complete(bar, b.x, nloc, nx); b.st[0] = nloc; b.st[1] = nx; }
        const unsigned old = xb_add(&bar[XB_XSUB(b.x)], 1u);
        const unsigned gen = old / nloc;
        if (old + 1u == (gen + 1u) * nloc) {
            __builtin_amdgcn_fence(__ATOMIC_RELEASE, "agent");
            asm volatile("s_waitcnt vmcnt(0)" ::: "memory");
            const unsigned og = xb_add(&bar[XB_TOP], 1u);
            const unsigned tg = og / nx;
            if (og + 1u == (tg + 1u) * nx) xb_add(&bar[XB_TOPGEN], 1u);
            else XB_SPIN(xb_ld(&bar[XB_TOPGEN]) == tg, bar);
            __builtin_amdgcn_fence(__ATOMIC_ACQUIRE, "agent");
            xb_add(&bar[XB_XGEN(b.x)], 1u);
            asm volatile("s_waitcnt vmcnt(0)" ::: "memory");
        } else {
            XB_SPIN(xb_ld(&bar[XB_XGEN(b.x)]) == gen, bar);
            __builtin_amdgcn_fence(__ATOMIC_ACQUIRE, "agent");
            asm volatile("s_waitcnt vmcnt(0)" ::: "memory");
        }
    }
    __syncthreads();
}

struct Ctx {
    LAS unsigned char* lds;
    int tid, lane, wave, G, bx;
    const float *x, *c, *ctx, *c_ctx, *w_ada, *b_ada, *norm_g, *w_in, *w_out, *ret_decay, *ret_gn, *hgrn_lb, *hgrn_gn, *mlstm_conv, *mlstm_gate_b, *mlstm_gn,
                *w_ffn1, *w_ffn3, *w_ffn2, *w_router, *w_exp1, *w_exp3, *w_exp2;
    float* out; unsigned char* ws;
};
#define WSP(T, off) ((T*)(C.ws + (off)))
__device__ __forceinline__ void tr_item(const float* W, int Npitch, bf16* WT, int Kd, int k0, int n0, int drow0, LAS float* scr, int lane) {
#pragma unroll 8
    for (int i = 0; i < 32; ++i) { const int kk = 2 * i + (lane >> 5); scr[kk * 33 + (lane & 31)] = W[(size_t)(k0 + kk) * Npitch + n0 + (lane & 31)]; }
    LDS_WAIT(); asm volatile("" ::: "memory");
    const int c = lane & 7;
#pragma unroll
    for (int j = 0; j < 4; ++j) { const int n = (lane >> 3) + 8 * j; const LAS float* s = scr + (8 * c) * 33 + n;
        v4u o; o.x = pk2(s[0 * 33], s[1 * 33]); o.y = pk2(s[2 * 33], s[3 * 33]); o.z = pk2(s[4 * 33], s[5 * 33]); o.w = pk2(s[6 * 33], s[7 * 33]);
        *(v4u*)(WT + (size_t)(drow0 + n) * Kd + k0 + 8 * c) = o; }
    LDS_WAIT(); asm volatile("" ::: "memory");
}
__device__ __forceinline__ void tr_item8(const float* W, int Npitch, unsigned char* WT, int Kd, int k0, int n0, int drow0, float scale, LAS float* scr, int lane) {
#pragma unroll 8
    for (int i = 0; i < 32; ++i) { const int kk = 2 * i + (lane >> 5); scr[kk * 33 + (lane & 31)] = W[(size_t)(k0 + kk) * Npitch + n0 + (lane & 31)]; }
    LDS_WAIT(); asm volatile("" ::: "memory");
    const int c = lane & 7;
#pragma unroll
    for (int j = 0; j < 4; ++j) { const int n = (lane >> 3) + 8 * j; const LAS float* s = scr + (8 * c) * 33 + n;
        v2u o; o.x = pg8::pk4_fp8(s[0 * 33] * scale, s[1 * 33] * scale, s[2 * 33] * scale, s[3 * 33] * scale); o.y = pg8::pk4_fp8(s[4 * 33] * scale, s[5 * 33] * scale, s[6 * 33] * scale, s[7 * 33] * scale);
        *(v2u*)(WT + (size_t)(drow0 + n) * Kd + k0 + 8 * c) = o; }
    LDS_WAIT(); asm volatile("" ::: "memory");
}
__device__ __forceinline__ void phase_prologue(const Ctx& C) {
    LAS float* scr = (LAS float*)(C.lds + C.wave * 16384);
    int lane0 = C.lane; asm volatile("" : "+v"(lane0));
    const int gw = C.bx * NWAVES + C.wave, NGW = C.G * NWAVES, lane = lane0;
    constexpr int N_ADA = 2 * 16 * 48;
    constexpr int I_IN = 32 * 240, I_OUT = 32 * 64, I_F = 5632;
    constexpr int N_TR = 2 * I_IN + 2 * I_OUT + 27 * I_F;
    for (int it = gw; it < N_ADA + N_TR; it += NGW) {
        if (it < N_ADA) {
            const int layer = it / 768, slice = (it % 768) / 48, cb = it % 48, k0 = slice * 128, c0 = cb * 256 + 4 * lane;
#pragma unroll
            for (int j = 0; j < 10; ++j) { const int idx = lane + 64 * j, v = idx >> 7, k = idx & 127; const float s = v < 4 ? C.c[v * D + k0 + k] : C.c_ctx[k0 + k]; scr[idx] = siluf_(s); }
            LDS_WAIT(); asm volatile("" ::: "memory");
            f32x4 acc[5];
#pragma unroll
            for (int v = 0; v < 5; ++v) acc[v] = (f32x4){0.f, 0.f, 0.f, 0.f};
            const float* wp = C.w_ada + ((size_t)layer * D + k0) * 12288 + c0;
#pragma unroll 8
            for (int k = 0; k < 128; ++k) { const f32x4 w = *(const f32x4*)(wp + (size_t)k * 12288);
#pragma unroll
                for (int v = 0; v < 5; ++v) acc[v] += w * scr[v * 128 + k]; }
            float* mp = WSP(float, WS_MODP) + ((size_t)(layer * 16 + slice) * 5) * 12288 + c0;
#pragma unroll
            for (int v = 0; v < 5; ++v) *(f32x4*)(mp + (size_t)v * 12288) = acc[v];
            LDS_WAIT(); asm volatile("" ::: "memory");
            continue;
        }
        int r = it - N_ADA;
        if (r < 2 * I_IN) { const int l = r / I_IN, q = r % I_IN, kb = q / 240, nb = q % 240;
            tr_item(C.w_in + (size_t)l * D * NPW, NPW, WSP(bf16, WS_WIN) + (size_t)l * NP * D, D, 64 * kb, 32 * nb, 32 * nb, scr, lane); continue; }
        r -= 2 * I_IN;
        if (r < 2 * I_OUT) { const int l = r / I_OUT, q = r % I_OUT, kb = q / 64, nb = q % 64;
            tr_item(C.w_out + (size_t)l * D * D, D, WSP(bf16, WS_WOUT) + (size_t)l * D * D, D, 64 * kb, 32 * nb, 32 * nb, scr, lane); continue; }
        r -= 2 * I_OUT;
        const int m = r / I_F, q = r % I_F;
        const bool down = (m == 2) || (m >= 19);
        if (!down) {
            const int half = (m == 1 || (m >= 11 && m < 19)) ? 1 : 0;
            const int e = m < 3 ? -1 : (m < 11 ? m - 3 : m - 11);
            const float* src = e < 0 ? (half ? C.w_ffn3 : C.w_ffn1) : (half ? C.w_exp3 : C.w_exp1) + (size_t)e * D * DFF;
            const int kb = q / 176, nb = q % 176, n0 = 32 * nb, drow0 = (n0 >> 7) * 256 + (n0 & 127) + 128 * half;
            if (e < 0) tr_item(src, DFF, WSP(bf16, WS_WF13), D, 64 * kb, n0, drow0, scr, lane);
            else tr_item8(src, DFF, WSP(unsigned char, WS_WE13) + (size_t)e * 2 * DFF * D, D, 64 * kb, n0, drow0, W13_SCALE, scr, lane);
        } else {
            const int e = m == 2 ? -1 : m - 19;
            const float* src = e < 0 ? C.w_ffn2 : C.w_exp2 + (size_t)e * DFF * D;
            const int kb = q / 64, nb = q % 64;
            if (e < 0) tr_item(src, D, WSP(bf16, WS_WF2), DFF, 64 * kb, 32 * nb, 32 * nb, scr, lane);
            else tr_item8(src, D, WSP(unsigned char, WS_WE2) + (size_t)e * D * DFF, DFF, 64 * kb, 32 * nb, 32 * nb, W2_SCALE, scr, lane);
        }
    }
}
__device__ __forceinline__ f32x4 modsum(const Ctx& C, int l, int v, int j, int col4) {
    f32x4 s = *(const f32x4*)(C.b_ada + (size_t)l * 12288 + j * D + col4);
    const float* mp = WSP(float, WS_MODP) + ((size_t)(l * 16) * 5 + v) * 12288 + j * D + col4;
#pragma unroll 4
    for (int sl = 0; sl < 16; ++sl) s += *(const f32x4*)(mp + (size_t)sl * 5 * 12288);
    return s;
}
__device__ __forceinline__ void expert_offsets(const Ctx& C, int (&cnt)[8], int (&off)[9]) {
    const unsigned* ctl = WSP(unsigned, WS_CTL);
    off[0] = 0;
#pragma unroll
    for (int e = 0; e < 8; ++e) { cnt[e] = (int)__hip_atomic_load(ctl + CW_CNT + 64 * e, __ATOMIC_RELAXED, __HIP_MEMORY_SCOPE_AGENT); off[e + 1] = off[e] + ((cnt[e] + 255) & ~255); }
}
template <int MODE> __device__ __forceinline__ void row_phase(const Ctx& C, int layer) {
    constexpr bool UPD = MODE != 0, NRM = MODE != 3, GATES = (MODE == 0 || MODE == 2);
    const bool ROUTER = (MODE == 1 && layer == 1), lat_only = (MODE == 3) || ROUTER, from_inputs = (MODE == 0) || (MODE == 1 && layer == 0);
    const int lu = (MODE == 2) ? 0 : layer, ju = (MODE == 1) ? 2 : 5, ku = (MODE == 1) ? 1 : 3;
    const int ln = (MODE == 2) ? 1 : layer, kn = (MODE == 1) ? 2 : 0, jsh = (MODE == 1) ? 3 : 0, jsc = (MODE == 1) ? 4 : 1;
    LAS float* GV = (LAS float*)C.lds; LAS float* AV = GV + 2048; LAS float* BV = GV + 4096; LAS float* WG = GV + 6144;
    int tid0 = C.tid; asm volatile("" : "+v"(tid0));
    const int tid = tid0, lane = tid & 63, wave = C.wave;
    float* X = WSP(float, WS_X); const float* Y = WSP(float, WS_Y); bf16* H = WSP(bf16, WS_H);
    __syncthreads();
    if (GATES) { const float* wi = C.w_in + (size_t)ln * D * NPW + NP;
        for (int idx = tid; idx < D * 16; idx += NTHR) { const int col = idx >> 4, g = idx & 15; WG[g * D + col] = wi[(size_t)col * NPW + g]; } }
    if (ROUTER) { for (int idx = tid; idx < D * 8; idx += NTHR) { const int col = idx >> 3, e = idx & 7; WG[e * D + col] = C.w_router[idx]; } }
    int cnt[8], off[9];
    if (MODE == 3) expert_offsets(C, cnt, off);
    for (int chunk = C.bx; chunk < 256; chunk += C.G) {
        const int b = chunk >> 6;
        int nrows, rbase, nctx;
        if (lat_only) { nrows = 32; rbase = b * TB + LC + (chunk & 63) * 32; nctx = 0; }
        else { nrows = 36; rbase = chunk * 36; nctx = b * TB + LC - rbase; nctx = nctx < 0 ? 0 : (nctx > 36 ? 36 : nctx); }
        for (int seg = 0; seg < 2; ++seg) {
            const int i0 = seg ? nctx : 0, i1 = seg ? nrows : nctx;
            if (i0 >= i1) continue;
            const int v = seg ? b : 4, col4 = tid * 4;
            __syncthreads();
            if (UPD) { const f32x4 g = modsum(C, lu, v, ju, col4) * *(const f32x4*)(C.norm_g + (size_t)(lu * 4 + ku) * D + col4); *(LAS f32x4*)(GV + col4) = g; }
            if (NRM) { const f32x4 sc = modsum(C, ln, v, jsc, col4), sh = modsum(C, ln, v, jsh, col4);
                *(LAS f32x4*)(AV + col4) = *(const f32x4*)(C.norm_g + (size_t)(ln * 4 + kn) * D + col4) * (sc + 1.0f); *(LAS f32x4*)(BV + col4) = sh; }
            __syncthreads();
            for (int i = i0 + wave; i < i1; i += NWAVES) {
                const int row = rbase + i, tin = row - b * TB;
                const float* xsrc = from_inputs ? (tin < LC ? C.ctx + ((size_t)b * LC + tin) * D : C.x + ((size_t)b * SEQ + (tin - LC)) * D) : X + (size_t)row * D;
                f32x4 xv[8];
#pragma unroll
                for (int j = 0; j < 8; ++j) xv[j] = *(const f32x4*)(xsrc + 4 * lane + 256 * j);
                if (UPD) {
                    f32x4 yv[8];
                    if (MODE == 3) {
                        const int tok = b * SEQ + (tin - LC);
                        const int* ti = WSP(int, WS_TOKINFO) + (size_t)tok * 8;
                        const int e0 = ti[0], p0 = ti[1], e1 = ti[2], p1 = ti[3]; const float g0 = __builtin_bit_cast(float, ti[4]), g1 = __builtin_bit_cast(float, ti[5]);
                        int o0 = 0, o1 = 0;
#pragma unroll
                        for (int e = 0; e < 8; ++e) { o0 = (e0 == e) ? off[e] : o0; o1 = (e1 == e) ? off[e] : o1; }
                        const float* y0 = WSP(float, WS_YS) + (size_t)(o0 + p0) * D; const float* y1 = WSP(float, WS_YS) + (size_t)(o1 + p1) * D;
#pragma unroll
                        for (int j = 0; j < 8; ++j) yv[j] = *(const f32x4*)(y0 + 4 * lane + 256 * j) * g0 + *(const f32x4*)(y1 + 4 * lane + 256 * j) * g1;
                    } else {
#pragma unroll
                        for (int j = 0; j < 8; ++j) yv[j] = *(const f32x4*)(Y + (size_t)row * D + 4 * lane + 256 * j);
                    }
                    float ss = 0.f;
#pragma unroll
                    for (int j = 0; j < 8; ++j) ss += (yv[j].x * yv[j].x + yv[j].y * yv[j].y) + (yv[j].z * yv[j].z + yv[j].w * yv[j].w);
                    const float rs = 1.0f / sqrtf(wave_sum(ss) * (1.0f / D) + NORM_EPS);
                    float* xdst = (MODE == 3) ? C.out + ((size_t)b * SEQ + (tin - LC)) * D : X + (size_t)row * D;
#pragma unroll
                    for (int j = 0; j < 8; ++j) { xv[j] += *(const LAS f32x4*)(GV + 4 * lane + 256 * j) * (yv[j] * rs); *(f32x4*)(xdst + 4 * lane + 256 * j) = xv[j]; }
                }
                if (NRM) {
                    float ss = 0.f;
#pragma unroll
                    for (int j = 0; j < 8; ++j) ss += (xv[j].x * xv[j].x + xv[j].y * xv[j].y) + (xv[j].z * xv[j].z + xv[j].w * xv[j].w);
                    const float rs = 1.0f / sqrtf(wave_sum(ss) * (1.0f / D) + NORM_EPS);
#pragma unroll
                    for (int j = 0; j < 8; ++j) { xv[j] = (xv[j] * rs) * *(const LAS f32x4*)(AV + 4 * lane + 256 * j) + *(const LAS f32x4*)(BV + 4 * lane + 256 * j);
                        if (ROUTER) { *(unsigned*)((unsigned char*)H + (size_t)row * D + 4 * lane + 256 * j) = pg8::pk4_fp8(xv[j].x * X8_SCALE, xv[j].y * X8_SCALE, xv[j].z * X8_SCALE, xv[j].w * X8_SCALE); }
                        else { v2u w; w.x = pk2(xv[j].x, xv[j].y); w.y = pk2(xv[j].z, xv[j].w); *(v2u*)(H + (size_t)row * D + 4 * lane + 256 * j) = w; } }
                    if (GATES) {
                        float outv = 0.f;
#pragma unroll 1
                        for (int g = 0; g < 16; ++g) { float a = 0.f;
#pragma unroll
                            for (int j = 0; j < 8; ++j) { const f32x4 w = *(const LAS f32x4*)(WG + g * D + 4 * lane + 256 * j); a += (xv[j].x * w.x + xv[j].y * w.y) + (xv[j].z * w.z + xv[j].w * w.w); }
                            a = wave_sum(a); outv = (lane == g) ? a : outv; }
                        if (lane < 16) WSP(float, WS_G16)[(size_t)row * 16 + lane] = outv;
                    }
                    if (ROUTER) {
                        int e0 = 0, e1 = 0; float v0 = -3.0e38f, v1 = -3.0e38f;
#pragma unroll 1
                        for (int e = 0; e < 8; ++e) { float a = 0.f;
#pragma unroll
                            for (int j = 0; j < 8; ++j) { const f32x4 w = *(const LAS f32x4*)(WG + e * D + 4 * lane + 256 * j); a += (xv[j].x * w.x + xv[j].y * w.y) + (xv[j].z * w.z + xv[j].w * w.w); }
                            a = wave_sum(a);
                            if (a > v0) { v1 = v0; e1 = e0; v0 = a; e0 = e; } else if (a > v1) { v1 = a; e1 = e; } }
                        if (lane == 0) {
                            const float g1 = 1.0f / (1.0f + __expf(v0 - v1)), g0 = 1.0f - g1;
                            unsigned* ctl = WSP(unsigned, WS_CTL);
                            const int tok = b * SEQ + (tin - LC);
                            const int p0 = (int)__hip_atomic_fetch_add(ctl + CW_CNT + 64 * e0, 1u, __ATOMIC_RELAXED, __HIP_MEMORY_SCOPE_AGENT);
                            const int p1 = (int)__hip_atomic_fetch_add(ctl + CW_CNT + 64 * e1, 1u, __ATOMIC_RELAXED, __HIP_MEMORY_SCOPE_AGENT);
                            WSP(int, WS_LIST)[e0 * 8192 + p0] = tok; WSP(int, WS_LIST)[e1 * 8192 + p1] = tok;
                            int* ti = WSP(int, WS_TOKINFO) + (size_t)tok * 8;
                            ti[0] = e0; ti[1] = p0; ti[2] = e1; ti[3] = p1; ti[4] = __builtin_bit_cast(int, g0); ti[5] = __builtin_bit_cast(int, g1);
                        }
                    }
                }
            }
        }
    }
    __syncthreads();
}
__device__ __forceinline__ void phase_gather(const Ctx& C) {
    int cnt[8], off[9]; expert_offsets(C, cnt, off);
    int lane0 = C.lane; asm volatile("" : "+v"(lane0));
    const int gw = C.bx * NWAVES + C.wave, NGW = C.G * NWAVES, lane = lane0;
    const unsigned char* H = WSP(unsigned char, WS_H); unsigned char* HG = WSP(unsigned char, WS_HG);
    for (int slot = gw; slot < off[8]; slot += NGW) {
        int e = 0, oe = 0, ce = cnt[0];
#pragma unroll
        for (int j = 1; j < 8; ++j) if (slot >= off[j]) { e = j; oe = off[j]; ce = cnt[j]; }
        const int pos = slot - oe;
        v4u d[2];
        if (pos < ce) { const int tok = WSP(int, WS_LIST)[e * 8192 + pos]; const size_t row = (size_t)(tok >> 11) * TB + LC + (tok & 2047);
#pragma unroll
            for (int j = 0; j < 2; ++j) d[j] = *(const v4u*)(H + row * D + 16 * lane + 1024 * j);
        } else {
#pragma unroll
            for (int j = 0; j < 2; ++j) d[j] = (v4u){0u, 0u, 0u, 0u};
        }
#pragma unroll
        for (int j = 0; j < 2; ++j) *(v4u*)(HG + (size_t)slot * D + 16 * lane + 1024 * j) = d[j];
    }
}
#ifndef GRPMASK
#define GRPMASK 7
#endif
__device__ __forceinline__ int chain_chunk(int dir, int step) { return dir == 0 ? step : (step == 0 ? 1 : (step == 1 ? 0 : 19 - step)); }
__device__ __forceinline__ void unpack8(const v4u w, float (&f)[8]) { f[0] = bflo(w.x); f[1] = bfhi(w.x); f[2] = bflo(w.y); f[3] = bfhi(w.y); f[4] = bflo(w.z); f[5] = bfhi(w.z); f[6] = bflo(w.w); f[7] = bfhi(w.w); }
__device__ __forceinline__ void store_state_tile(bf16* ST, int e, int d0, const f32x4 s) { v2u w; w.x = pk2(s[0], s[1]); w.y = pk2(s[2], s[3]); *(v2u*)(ST + (size_t)e * 128 + d0) = w; }
__device__ __forceinline__ void rotary16(float (&x1)[16], float (&x2)[16], int g, int tl, const LAS float* inv) {
    const float pos = (float)((g < 2) ? (tl >> 6) : (tl & 63));
#pragma unroll
    for (int i = 0; i < 16; ++i) { const float ang = pos * inv[16 * (g & 1) + i]; const float sn = __sinf(ang), cs = __cosf(ang); const float a = x1[i], b = x2[i]; x1[i] = a * cs - b * sn; x2[i] = b * cs + a * sn; }
}
__device__ __forceinline__ float scan_wave_sum(float v, int lane, bool bwd) {
#pragma unroll
    for (int o = 1; o < 64; o <<= 1) { const float t = bwd ? __shfl_down(v, o) : __shfl_up(v, o); const bool ok = bwd ? (lane + o < 64) : (lane >= o); v += ok ? t : 0.f; }
    return v;
}
__device__ __forceinline__ float scan_wave_max(float v, int lane, bool bwd) {
#pragma unroll
    for (int o = 1; o < 64; o <<= 1) { const float t = bwd ? __shfl_down(v, o) : __shfl_up(v, o); const bool ok = bwd ? (lane + o < 64) : (lane >= o); v = ok ? fmaxf(v, t) : v; }
    return v;
}
template <int GRP> struct RawStep;
template <> struct RawStep<0> { v4u a[4]; v4u v[2]; };
template <> struct RawStep<1> { v4u a[4]; v4u v[2]; f32x4 l[8]; };
template <> struct RawStep<2> { v4u a[12]; v4u v[2]; float g0, g1; };
template <int GRP> __device__ __forceinline__ void state_load(RawStep<GRP>& R, const Ctx& C, int b, int h, int dir, int es, int c, int s, int g) {
    const bf16* P = WSP(bf16, WS_P);
    const size_t row = (size_t)b * TB + 128 * c + s;
    const bf16* prow = P + row * NP;
    if constexpr (GRP == 0) { const bf16* kp = prow + 512 + h * 128 + 16 * g;
        R.a[0] = *(const v4u*)kp; R.a[1] = *(const v4u*)(kp + 8); R.a[2] = *(const v4u*)(kp + 64); R.a[3] = *(const v4u*)(kp + 72);
        const bf16* vp = prow + 1024 + h * 256 + 64 * es + 16 * g; R.v[0] = *(const v4u*)vp; R.v[1] = *(const v4u*)(vp + 8);
    } else if constexpr (GRP == 1) { const bf16* fp = prow + 3584 + dir * 512 + h * 128 + 32 * g;
        const float* lp = WSP(float, WS_LF) + row * 1024 + dir * 512 + h * 128 + 32 * g;
#pragma unroll
        for (int q = 0; q < 4; ++q) R.a[q] = *(const v4u*)(fp + 8 * q);
#pragma unroll
        for (int q = 0; q < 8; ++q) R.l[q] = *(const f32x4*)(lp + 4 * q);
        const bf16* vp = prow + 4608 + h * 128 + 64 * es + 16 * g; R.v[0] = *(const v4u*)vp; R.v[1] = *(const v4u*)(vp + 8);
    } else { const bf16* kp = prow + 6144 + h * 128 + 32 * g;
        const int tall = 128 * c + s, seg0 = c < 2 ? 0 : LC, seg1 = c < 2 ? LC : TB;
        const bf16* kpp = (tall - 1 >= seg0) ? kp - NP : kp; const bf16* kpn = (tall + 1 < seg1) ? kp + NP : kp;
#pragma unroll
        for (int q = 0; q < 4; ++q) { R.a[q] = *(const v4u*)(kp + 8 * q); R.a[4 + q] = *(const v4u*)(kpp + 8 * q); R.a[8 + q] = *(const v4u*)(kpn + 8 * q); }
        const bf16* vp = prow + 6656 + h * 128 + 64 * es + 16 * g; R.v[0] = *(const v4u*)vp; R.v[1] = *(const v4u*)(vp + 8);
        const float* gp = WSP(float, WS_G16) + row * 16; R.g0 = gp[8 + 4 * dir + h]; R.g1 = gp[4 * dir + h];
    }
}
template <int GRP> __device__ __forceinline__ void state_chain(const Ctx& C, int layer, int b, int h, int dir, int es) {
    LAS unsigned char* lds = C.lds;
    LAS unsigned char* KT = lds;
    LAS unsigned char* VT = lds + 34816;
    LAS float* LB = (LAS float*)(lds + 57344);
    LAS float* QT = (LAS float*)(lds + 124928);
    LAS float* SC = (LAS float*)(lds + 126976);
    const int w = C.wave, g = w >> 1;
    f32x4 S[5];
#pragma unroll
    for (int i = 0; i < 5; ++i) S[i] = (f32x4){0.f, 0.f, 0.f, 0.f};
    { const int tid = C.tid;
      if (GRP == 1 && tid < 128) { const int chn = h * 128 + tid; SC[640 + tid] = layer == 0 ? 0.0f : sigmoidf_(C.hgrn_lb[512 + chn] - C.hgrn_lb[chn]); }
      if (GRP == 2) { if (tid < 384) { const int j = tid >> 7, dd = tid & 127; SC[1024 + tid] = C.mlstm_conv[(size_t)layer * 3072 + j * 1024 + 512 + h * 128 + dd]; }
          for (int idx = tid; idx < 16 * 128; idx += NTHR) { const int er = idx >> 7, sc = idx & 127; *(LAS bf16*)(VT + (64 + er) * PIT + sc * 2) = (er == 0) ? (bf16)0x3F80 : (bf16)0; } } }
    const float lg = GRP == 0 ? logsigmoidf_(C.ret_decay[layer * 8 + dir * 4 + h]) : 0.0f;
    const float gbf = GRP == 2 ? C.mlstm_gate_b[layer * 16 + 8 + 4 * dir + h] : 0.f, gbi = GRP == 2 ? C.mlstm_gate_b[layer * 16 + 4 * dir + h] : 0.f;
    float mrun = 0.0f;
    RawStep<GRP> R;
    state_load<GRP>(R, C, b, h, dir, es, chain_chunk(dir, 0), C.tid & 127, g);
    LBAR();
#pragma unroll 1
    for (int step = 0; step < NCH; ++step) {
        int tid0 = C.tid; asm volatile("" : "+v"(tid0));
        const int tid = tid0, lane = tid & 63, fr = lane & 15, fq = lane >> 4, s = tid & 127;
        const int c = chain_chunk(dir, step);
        const RawStep<GRP> X = R;
        { const int cn = chain_chunk(dir, step + 1 < NCH ? step + 1 : step); state_load<GRP>(R, C, b, h, dir, es, cn, s, g); }
        float decay_s = 1.0f;
        const unsigned vw[8] = {X.v[0].x, X.v[0].y, X.v[0].z, X.v[0].w, X.v[1].x, X.v[1].y, X.v[1].z, X.v[1].w};
#pragma unroll
        for (int i = 0; i < 8; ++i) { *(LAS bf16*)(VT + (16 * g + 2 * i) * PIT + s * 2) = (bf16)(vw[i] & 0xffffu); *(LAS bf16*)(VT + (16 * g + 2 * i + 1) * PIT + s * 2) = (bf16)(vw[i] >> 16); }
        if constexpr (GRP == 0) {
            float k1[16], k2[16];
            { float t8[8];
              unpack8(X.a[0], t8);
#pragma unroll
              for (int i = 0; i < 8; ++i) k1[i] = t8[i];
              unpack8(X.a[1], t8);
#pragma unroll
              for (int i = 0; i < 8; ++i) k1[8 + i] = t8[i];
              unpack8(X.a[2], t8);
#pragma unroll
              for (int i = 0; i < 8; ++i) k2[i] = t8[i];
              unpack8(X.a[3], t8);
#pragma unroll
              for (int i = 0; i < 8; ++i) k2[8 + i] = t8[i]; }
            if (c >= 2) rotary16(k1, k2, g, 128 * (c - 2) + s, SC + 768);
            const int tau = dir ? 127 - s : s;
            const float wk = __expf((float)(127 - tau) * lg) * 0.08838834764831845f;
#pragma unroll
            for (int i = 0; i < 16; ++i) { *(LAS bf16*)(KT + (16 * g + i) * PIT + s * 2) = (bf16)f2bf(k1[i] * wk); *(LAS bf16*)(KT + (64 + 16 * g + i) * PIT + s * 2) = (bf16)f2bf(k2[i] * wk); }
            decay_s = __expf(128.0f * lg);
        } else if constexpr (GRP == 1) {
#pragma unroll
            for (int q = 0; q < 4; ++q) { const unsigned kw[4] = {X.a[q].x, X.a[q].y, X.a[q].z, X.a[q].w};
#pragma unroll
                for (int i = 0; i < 4; ++i) { *(LAS bf16*)(KT + (32 * g + 8 * q + 2 * i) * PIT + s * 2) = (bf16)(kw[i] & 0xffffu); *(LAS bf16*)(KT + (32 * g + 8 * q + 2 * i + 1) * PIT + s * 2) = (bf16)(kw[i] >> 16); } }
#pragma unroll
            for (int q = 0; q < 8; ++q) *(LAS f32x4*)(LB + s * 132 + 32 * g + 4 * q) = X.l[q];
            LBAR();
            {
                const int dq = tid & 127, q4 = tid >> 7; float pv[32];
#pragma unroll
                for (int i = 0; i < 32; ++i) pv[i] = LB[(32 * q4 + i) * 132 + dq];
                if (dir == 0) {
#pragma unroll
                    for (int i = 1; i < 32; ++i) pv[i] += pv[i - 1];
                } else {
#pragma unroll
                    for (int i = 30; i >= 0; --i) pv[i] += pv[i + 1];
                }
                QT[q4 * 128 + dq] = dir == 0 ? pv[31] : pv[0];
                LBAR();
                const float t0 = QT[dq], t1 = QT[128 + dq], t2 = QT[256 + dq], t3 = QT[384 + dq], bl = (t0 + t1) + (t2 + t3);
                float offv;
                if (dir == 0) offv = (q4 > 0 ? t0 : 0.f) + (q4 > 1 ? t1 : 0.f) + (q4 > 2 ? t2 : 0.f);
                else offv = (q4 < 3 ? t3 : 0.f) + (q4 < 2 ? t2 : 0.f) + (q4 < 1 ? t1 : 0.f);
                const float bo = bl - offv;
#pragma unroll
                for (int q = 0; q < 4; ++q) { LAS v4u* kp4 = (LAS v4u*)(KT + dq * PIT + (32 * q4 + 8 * q) * 2); float k8[8]; unpack8(*kp4, k8);
                    v4u o4; o4.x = pk2(k8[0] * __expf(bo - pv[8 * q + 0]), k8[1] * __expf(bo - pv[8 * q + 1])); o4.y = pk2(k8[2] * __expf(bo - pv[8 * q + 2]), k8[3] * __expf(bo - pv[8 * q + 3]));
                    o4.z = pk2(k8[4] * __expf(bo - pv[8 * q + 4]), k8[5] * __expf(bo - pv[8 * q + 5])); o4.w = pk2(k8[6] * __expf(bo - pv[8 * q + 6]), k8[7] * __expf(bo - pv[8 * q + 7]));
                    *kp4 = o4; }
            }
        } else {
            float bsc = 0.f, igv = 0.f;
            if (tid < 128) { igv = X.g1 + gbi; bsc = scan_wave_sum(logsigmoidf_(X.g0 + gbf), lane, dir != 0); if (lane == (dir ? 0 : 63)) SC[512 + w] = bsc; }
            LBAR();
            const float bl = SC[512] + SC[513];
            if (tid < 128) { if (dir == 0 ? (w == 1) : (w == 0)) bsc += SC[512 + (w ^ 1)];
                const float be = bl - bsc + igv; SC[384 + s] = be; const float mx = wave_max(be); if (lane == 0) SC[516 + w] = mx; }
            LBAR();
            const float mloc = fmaxf(SC[516], SC[517]), mnew = fmaxf(bl + mrun, mloc);
            decay_s = __expf(bl + mrun - mnew);
            const float ws = __expf(SC[384 + s] - mnew) * 0.08838834764831845f;
            const int tall = 128 * c + s, seg0 = c < 2 ? 0 : LC, seg1 = c < 2 ? LC : TB;
            const float wp = (tall - 1 >= seg0) ? 1.0f : 0.0f, wn = (tall + 1 < seg1) ? 1.0f : 0.0f;
#pragma unroll
            for (int q = 0; q < 4; ++q) { float a8[8], t8[8];
                unpack8(X.a[q], t8);
#pragma unroll
                for (int i = 0; i < 8; ++i) a8[i] = t8[i] * SC[1024 + 128 + 32 * g + 8 * q + i];
                unpack8(X.a[4 + q], t8);
#pragma unroll
                for (int i = 0; i < 8; ++i) a8[i] += t8[i] * (wp * SC[1024 + 32 * g + 8 * q + i]);
                unpack8(X.a[8 + q], t8);
#pragma unroll
                for (int i = 0; i < 8; ++i) a8[i] += t8[i] * (wn * SC[1024 + 256 + 32 * g + 8 * q + i]);
#pragma unroll
                for (int i = 0; i < 8; ++i) *(LAS bf16*)(KT + (32 * g + 8 * q + i) * PIT + s * 2) = (bf16)f2bf(siluf_(a8[i]) * ws); }
            if (es == 0 && tid == 0) WSP(float, WS_MSM)[((b * 4 + h) * 2 + dir) * NCH + c] = mrun;
            mrun = mnew;
        }
        LBAR();
        const size_t sidx = (size_t)(((b * 4 + h) * 2 + dir) * NCH + c);
        const int d0 = 16 * w + 4 * fq;
        if constexpr (GRP == 0) { bf16* ST = WSP(bf16, WS_RST) + sidx * (256 * 128);
#pragma unroll
            for (int ei = 0; ei < 4; ++ei) store_state_tile(ST, 64 * es + 16 * ei + fr, d0, S[ei]);
#pragma unroll
            for (int ei = 0; ei < 4; ++ei) S[ei] *= decay_s;
        } else if constexpr (GRP == 1) { bf16* ST = WSP(bf16, WS_HST) + sidx * (128 * 128);
#pragma unroll
            for (int ei = 0; ei < 4; ++ei) store_state_tile(ST, 64 * es + 16 * ei + fr, d0, S[ei]);
            f32x4 dv;
#pragma unroll
            for (int r = 0; r < 4; ++r) { const int dd = d0 + r; dv[r] = __expf((QT[dd] + QT[128 + dd]) + (QT[256 + dd] + QT[384 + dd])); }
#pragma unroll
            for (int ei = 0; ei < 4; ++ei) S[ei] *= dv;
        } else { bf16* ST = WSP(bf16, WS_MST) + sidx * (144 * 128);
#pragma unroll
            for (int ei = 0; ei < 4; ++ei) store_state_tile(ST, 64 * es + 16 * ei + fr, d0, S[ei]);
            if (es == 0) store_state_tile(ST, 128 + fr, d0, S[4]);
#pragma unroll
            for (int ei = 0; ei < 5; ++ei) S[ei] *= decay_s;
        }
#pragma unroll
        for (int kk4 = 0; kk4 < 4; ++kk4) { const bf16x8 a = ldsfrag(KT, 16 * w + fr, PIT, kk4, fq);
#pragma unroll
            for (int ei = 0; ei < 4; ++ei) S[ei] = MFMA(a, ldsfrag(VT, 16 * ei + fr, PIT, kk4, fq), S[ei]);
            if constexpr (GRP == 2) S[4] = MFMA(a, ldsfrag(VT, 64 + fr, PIT, kk4, fq), S[4]); }
        LBAR();
    }
}
#ifndef PROBE_GRP
#define PROBE_GRP -1
#endif
__device__ __forceinline__ void phase_state(const Ctx& C, int layer, int probe_rep = 0) {
    LAS float* SC = (LAS float*)(C.lds + 126976);
    LBAR();
    if (C.tid < 32) SC[768 + C.tid] = __expf(-(float)C.tid * (9.210340371976184f / 32.0f));
    for (int ch = C.bx; ch < 256; ch += C.G) {
        const int grp = ch < 128 ? 0 : (ch < 192 ? 1 : 2);
        const int xx = grp == 0 ? ch : (grp == 1 ? ch - 128 : ch - 192);
        const int b = grp == 0 ? (xx >> 5) : (xx >> 4), h = grp == 0 ? ((xx >> 3) & 3) : ((xx >> 2) & 3), dir = grp == 0 ? ((xx >> 2) & 1) : ((xx >> 1) & 1), es = grp == 0 ? (xx & 3) : (xx & 1);
        if (PROBE_GRP >= 0 && probe_rep && grp != PROBE_GRP) continue;
        LBAR();
        if (grp == 0) state_chain<0>(C, layer, b, h, dir, es);
        else if (grp == 1) state_chain<1>(C, layer, b, h, dir, es);
        else state_chain<2>(C, layer, b, h, dir, es);
    }
}
__device__ __forceinline__ void stage_vt128(LAS unsigned char* VT, const bf16* vp  , int g, int s) {
#pragma unroll
    for (int q = 0; q < 4; ++q) { const v4u v = *(const v4u*)(vp + 8 * q); const unsigned vw[4] = {v.x, v.y, v.z, v.w};
#pragma unroll
        for (int i = 0; i < 4; ++i) { *(LAS bf16*)(VT + (32 * g + 8 * q + 2 * i) * PIT + s * 2) = (bf16)(vw[i] & 0xffffu); *(LAS bf16*)(VT + (32 * g + 8 * q + 2 * i + 1) * PIT + s * 2) = (bf16)(vw[i] >> 16); } }
}
__device__ __forceinline__ void stage_rot16(LAS unsigned char* dst, const bf16* src, bool rot, int g, int tl, const LAS float* inv, float scale, int s) {
    float x1[16], x2[16], t8[8];
    unpack8(*(const v4u*)src, t8);
#pragma unroll
    for (int i = 0; i < 8; ++i) x1[i] = t8[i];
    unpack8(*(const v4u*)(src + 8), t8);
#pragma unroll
    for (int i = 0; i < 8; ++i) x1[8 + i] = t8[i];
    unpack8(*(const v4u*)(src + 64), t8);
#pragma unroll
    for (int i = 0; i < 8; ++i) x2[i] = t8[i];
    unpack8(*(const v4u*)(src + 72), t8);
#pragma unroll
    for (int i = 0; i < 8; ++i) x2[8 + i] = t8[i];
    if (rot) rotary16(x1, x2, g, tl, inv);
    v4u o;
    o.x = pk2(x1[0] * scale, x1[1] * scale); o.y = pk2(x1[2] * scale, x1[3] * scale); o.z = pk2(x1[4] * scale, x1[5] * scale); o.w = pk2(x1[6] * scale, x1[7] * scale); *(LAS v4u*)(dst + s * PIT + (16 * g) * 2) = o;
    o.x = pk2(x1[8] * scale, x1[9] * scale); o.y = pk2(x1[10] * scale, x1[11] * scale); o.z = pk2(x1[12] * scale, x1[13] * scale); o.w = pk2(x1[14] * scale, x1[15] * scale); *(LAS v4u*)(dst + s * PIT + (16 * g + 8) * 2) = o;
    o.x = pk2(x2[0] * scale, x2[1] * scale); o.y = pk2(x2[2] * scale, x2[3] * scale); o.z = pk2(x2[4] * scale, x2[5] * scale); o.w = pk2(x2[6] * scale, x2[7] * scale); *(LAS v4u*)(dst + s * PIT + (64 + 16 * g) * 2) = o;
    o.x = pk2(x2[8] * scale, x2[9] * scale); o.y = pk2(x2[10] * scale, x2[11] * scale); o.z = pk2(x2[12] * scale, x2[13] * scale); o.w = pk2(x2[14] * scale, x2[15] * scale); *(LAS v4u*)(dst + s * PIT + (64 + 16 * g + 8) * 2) = o;
    asm volatile("" ::: "memory");
}
template <int DV, int ACT> __device__ __forceinline__ void mix_store(const LAS unsigned char* OT, int OPB, const bf16* pgate  , const float* gn, bf16* mix  , int tid) {
    constexpr int CPR = DV / 8;
#pragma unroll
    for (int it = 0; it < (128 * CPR) / NTHR; ++it) { const int idx = tid + NTHR * it, row = idx / CPR, chn = idx % CPR;
        float o8[8], g8[8]; unpack8(*(const LAS v4u*)(OT + row * OPB + chn * 16), o8); unpack8(*(const v4u*)(pgate + (size_t)row * NP + chn * 8), g8);
        const f32x4 n0 = *(const f32x4*)(gn + chn * 8), n1 = *(const f32x4*)(gn + chn * 8 + 4);
        const float nn[8] = {n0[0], n0[1], n0[2], n0[3], n1[0], n1[1], n1[2], n1[3]};
        float r8[8];
#pragma unroll
        for (int i = 0; i < 8; ++i) r8[i] = o8[i] * nn[i] * g8[i];
        v4u o; o.x = pk2(r8[0], r8[1]); o.y = pk2(r8[2], r8[3]); o.z = pk2(r8[4], r8[5]); o.w = pk2(r8[6], r8[7]);
        *(v4u*)(mix + (size_t)row * D + chn * 8) = o; }
}
__device__ __forceinline__ void phase_out(const Ctx& C, int layer, int probe_rep = 0) {
    LAS unsigned char* lds = C.lds;
    const int w = C.wave, g = w >> 1;
    const bf16* P = WSP(bf16, WS_P); bf16* MIX = WSP(bf16, WS_MIX);
    LAS float* SC = (LAS float*)(lds + 139264);
    LBAR();
    if (C.tid < 32) SC[2048 + C.tid] = __expf(-(float)C.tid * (9.210340371976184f / 32.0f));
    LBAR();
    constexpr int NU = 3 * NB * 4 * NCH;
    for (int u = C.bx; u < NU; u += C.G) {
        int tid0 = C.tid; asm volatile("" : "+v"(tid0));
        const int tid = tid0, lane = tid & 63, fr = lane & 15, fq = lane >> 4, s = tid & 127;
        const int grp = u / 288, uu = u % 288, b = uu / 72, h = (uu % 72) / NCH, c = uu % NCH;
        if (PROBE_GRP >= 0 && probe_rep && grp != PROBE_GRP) continue;
        const size_t row0 = (size_t)b * TB + 128 * c;
        const bf16* prow = P + (row0 + s) * NP;
        const size_t sidx_f = (size_t)(((b * 4 + h) * 2 + 0) * NCH + c), sidx_b = (size_t)(((b * 4 + h) * 2 + 1) * NCH + c);
#ifndef GRPMASK
#define GRPMASK 7
#endif
        if ((GRPMASK & 1) && grp == 0) {
            LAS unsigned char* QL = lds; LAS unsigned char* KL = lds + 34816; LAS unsigned char* AL = lds + 69632; LAS unsigned char* VT = lds + 104448;
            const float lgf = logsigmoidf_(C.ret_decay[layer * 8 + h]), lgb = logsigmoidf_(C.ret_decay[layer * 8 + 4 + h]);
            stage_rot16(QL, prow + h * 128 + 16 * g, c >= 2, g, 128 * (c - 2) + s, SC + 2048, 1.0f, s);
            stage_rot16(KL, prow + 512 + h * 128 + 16 * g, c >= 2, g, 128 * (c - 2) + s, SC + 2048, 0.08838834764831845f, s);
            LBAR();
            bf16x8 qf[4];
#pragma unroll
            for (int kk = 0; kk < 4; ++kk) qf[kk] = ldsfrag(QL, 16 * w + fr, PIT, kk, fq);
            {   f32x4 sa[8];
#pragma unroll
                for (int j = 0; j < 8; ++j) sa[j] = (f32x4){0.f, 0.f, 0.f, 0.f};
#pragma unroll
                for (int kk = 0; kk < 4; ++kk)
#pragma unroll
                    for (int j = 0; j < 8; ++j) sa[j] = MFMA(qf[kk], ldsfrag(KL, 16 * j + fr, PIT, kk, fq), sa[j]);
#pragma unroll
                for (int j = 0; j < 8; ++j)
#pragma unroll
                    for (int r = 0; r < 4; ++r) { const int t = 16 * w + 4 * fq + r, ss = 16 * j + fr; const float dl = (float)(t - ss);
                        const float dm = (ss <= t ? __expf(dl * lgf) : 0.f) + (ss >= t ? __expf(-dl * lgb) : 0.f);
                        *(LAS bf16*)(AL + t * PIT + ss * 2) = (bf16)f2bf(sa[j][r] * dm); }
            }
            f32x4 o[2][8];
            float dqf[4], dqb[4];
#pragma unroll
            for (int r = 0; r < 4; ++r) { const int t = 16 * w + 4 * fq + r; dqf[r] = __expf((float)(t + 1) * lgf); dqb[r] = __expf((float)(128 - t) * lgb); }
#pragma unroll
            for (int half = 0; half < 2; ++half) {
                if (half == 1) LBAR();
                stage_vt128(VT, prow + 1024 + h * 256 + 128 * half + 32 * g, g, s);
                LBAR();
#pragma unroll
                for (int ei = 0; ei < 8; ++ei) o[half][ei] = (f32x4){0.f, 0.f, 0.f, 0.f};
#pragma unroll
                for (int kk = 0; kk < 4; ++kk) { const bf16x8 a = ldsfrag(AL, 16 * w + fr, PIT, kk, fq);
#pragma unroll
                    for (int ei = 0; ei < 8; ++ei) o[half][ei] = MFMA(a, ldsfrag(VT, 16 * ei + fr, PIT, kk, fq), o[half][ei]); }
#pragma unroll 1
                for (int dir = 0; dir < 2; ++dir) {
                    const bf16* ST = WSP(bf16, WS_RST) + (dir ? sidx_b : sidx_f) * (256 * 128) + (size_t)(128 * half) * 128 + (size_t)fr * 128 + 8 * fq;
                    f32x4 ia[8];
#pragma unroll
                    for (int ei = 0; ei < 8; ++ei) ia[ei] = (f32x4){0.f, 0.f, 0.f, 0.f};
#pragma unroll
                    for (int kk = 0; kk < 4; ++kk) {
#pragma unroll
                        for (int ei = 0; ei < 8; ++ei) { const bf16x8 bb = *(const bf16x8*)(ST + ei * 2048 + 32 * kk); ia[ei] = MFMA(qf[kk], bb, ia[ei]); }
                        __builtin_amdgcn_sched_barrier(0); }
#pragma unroll
                    for (int ei = 0; ei < 8; ++ei)
#pragma unroll
                        for (int r = 0; r < 4; ++r) o[half][ei][r] += (dir ? dqb[r] : dqf[r]) * ia[ei][r];
                }
            }
            float rs[4];
#pragma unroll
            for (int r = 0; r < 4; ++r) { float q = 0.f;
#pragma unroll
                for (int half = 0; half < 2; ++half)
#pragma unroll
                    for (int ei = 0; ei < 8; ++ei) q += o[half][ei][r] * o[half][ei][r];
                rs[r] = 1.0f / sqrtf(sum16(q) * (1.0f / 256.0f) + NORM_EPS); }
            LBAR();
#pragma unroll
            for (int half = 0; half < 2; ++half)
#pragma unroll
                for (int ei = 0; ei < 8; ++ei)
#pragma unroll
                    for (int r = 0; r < 4; ++r) *(LAS bf16*)(lds + (16 * w + 4 * fq + r) * 528 + (128 * half + 16 * ei + fr) * 2) = (bf16)f2bf(o[half][ei][r] * rs[r]);
            LBAR();
            mix_store<256, 0>(lds, 528, P + row0 * NP + 2048 + h * 256, C.ret_gn + layer * 1024 + h * 256, MIX + row0 * D + h * 256, tid);
            LBAR();
        } else if ((GRPMASK & 2) && grp == 1) {
            LAS float* BB = (LAS float*)lds;
            LAS unsigned char* QL = lds + 67584; LAS unsigned char* KL = lds + 102400;
            LAS float* QT = (LAS float*)(lds + 137216);
            LAS unsigned char* AL = lds; LAS unsigned char* VT = lds + 34816;
            if (tid < 128) { const int chn = h * 128 + tid; SC[tid] = layer == 0 ? 0.0f : sigmoidf_(C.hgrn_lb[512 + chn] - C.hgrn_lb[chn]); }
            LBAR();
            f32x4 oa[8], aa[8];
#pragma unroll
            for (int j = 0; j < 8; ++j) { oa[j] = (f32x4){0.f, 0.f, 0.f, 0.f}; aa[j] = (f32x4){0.f, 0.f, 0.f, 0.f}; }
#pragma unroll 1
            for (int dir = 0; dir < 2; ++dir) {
                {   const bf16* fp = prow + 3584 + dir * 512 + h * 128 + 32 * g; const bf16* qp = prow + 3072 + h * 128 + 32 * g;
                    const float* lp = WSP(float, WS_LF) + (row0 + s) * 1024 + dir * 512 + h * 128 + 32 * g;
#pragma unroll
                    for (int q = 0; q < 8; ++q) *(LAS f32x4*)(BB + s * 132 + 32 * g + 4 * q) = *(const f32x4*)(lp + 4 * q);
#pragma unroll
                    for (int q = 0; q < 4; ++q) *(LAS v4u*)(KL + s * PIT + (32 * g + 8 * q) * 2) = *(const v4u*)(fp + 8 * q);
                    if (dir == 0) {
#pragma unroll
                        for (int q = 0; q < 4; ++q) *(LAS v4u*)(QL + s * PIT + (32 * g + 8 * q) * 2) = *(const v4u*)(qp + 8 * q); }
                }
                LBAR();
                {
                    const int dq = tid & 127, q4 = tid >> 7; float pv[32];
#pragma unroll
                    for (int i = 0; i < 32; ++i) pv[i] = BB[(32 * q4 + i) * 132 + dq];
                    if (dir == 0) {
#pragma unroll
                        for (int i = 1; i < 32; ++i) pv[i] += pv[i - 1];
                    } else {
#pragma unroll
                        for (int i = 30; i >= 0; --i) pv[i] += pv[i + 1];
                    }
                    QT[q4 * 128 + dq] = dir == 0 ? pv[31] : pv[0];
                    LBAR();
                    const float t0 = QT[dq], t1 = QT[128 + dq], t2 = QT[256 + dq], t3 = QT[384 + dq];
                    float offv;
                    if (dir == 0) offv = (q4 > 0 ? t0 : 0.f) + (q4 > 1 ? t1 : 0.f) + (q4 > 2 ? t2 : 0.f);
                    else offv = (q4 < 3 ? t3 : 0.f) + (q4 < 2 ? t2 : 0.f) + (q4 < 1 ? t1 : 0.f);
#pragma unroll
                    for (int i = 0; i < 32; ++i) BB[(32 * q4 + i) * 132 + dq] = pv[i] + offv;
                }
                LBAR();
                {   const int i = w, tr = dir == 0 ? 16 * i : 16 * i + 15;
                    const bf16* ST = WSP(bf16, WS_HST) + (dir ? sidx_b : sidx_f) * (128 * 128);
                    f32x4 td = (f32x4){0.f, 0.f, 0.f, 0.f};
#pragma unroll 1
                    for (int kk = 0; kk < 4; ++kk) {
                        const int dof = 32 * kk + 8 * fq;
                        const f32x4 bt0 = *(LAS f32x4*)(BB + (16 * i + fr) * 132 + dof), bt1 = *(LAS f32x4*)(BB + (16 * i + fr) * 132 + dof + 4);
                        const f32x4 rf0 = *(LAS f32x4*)(BB + tr * 132 + dof), rf1 = *(LAS f32x4*)(BB + tr * 132 + dof + 4);
                        float q8[8]; unpack8(*(const LAS v4u*)(QL + (16 * i + fr) * PIT + dof * 2), q8);
                        const float bt[8] = {bt0[0], bt0[1], bt0[2], bt0[3], bt1[0], bt1[1], bt1[2], bt1[3]}, rf[8] = {rf0[0], rf0[1], rf0[2], rf0[3], rf1[0], rf1[1], rf1[2], rf1[3]};
                        v4u qh, qe;
                        qh.x = pk2(q8[0] * __expf(bt[0] - rf[0]), q8[1] * __expf(bt[1] - rf[1])); qh.y = pk2(q8[2] * __expf(bt[2] - rf[2]), q8[3] * __expf(bt[3] - rf[3]));
                        qh.z = pk2(q8[4] * __expf(bt[4] - rf[4]), q8[5] * __expf(bt[5] - rf[5])); qh.w = pk2(q8[6] * __expf(bt[6] - rf[6]), q8[7] * __expf(bt[7] - rf[7]));
                        qe.x = pk2(q8[0] * __expf(bt[0]), q8[1] * __expf(bt[1])); qe.y = pk2(q8[2] * __expf(bt[2]), q8[3] * __expf(bt[3]));
                        qe.z = pk2(q8[4] * __expf(bt[4]), q8[5] * __expf(bt[5])); qe.w = pk2(q8[6] * __expf(bt[6]), q8[7] * __expf(bt[7]));
                        const bf16x8 qhf = __builtin_bit_cast(bf16x8, qh), qef = __builtin_bit_cast(bf16x8, qe);
#pragma unroll
                        for (int ei = 0; ei < 8; ++ei) { const bf16x8 bb = *(const bf16x8*)(ST + (size_t)(16 * ei + fr) * 128 + dof); oa[ei] = MFMA(qef, bb, oa[ei]); }
#pragma unroll
                        for (int j = 0; j < 8; ++j) {
                            if (dir == 0 ? (j <= i) : (j >= i)) {
                                const f32x4 bs0 = *(LAS f32x4*)(BB + (16 * j + fr) * 132 + dof), bs1 = *(LAS f32x4*)(BB + (16 * j + fr) * 132 + dof + 4);
                                float k8[8]; unpack8(*(const LAS v4u*)(KL + (16 * j + fr) * PIT + dof * 2), k8);
                                const float bs[8] = {bs0[0], bs0[1], bs0[2], bs0[3], bs1[0], bs1[1], bs1[2], bs1[3]};
                                v4u kh;
                                kh.x = pk2(k8[0] * __expf(fminf(rf[0] - bs[0], 60.f)), k8[1] * __expf(fminf(rf[1] - bs[1], 60.f))); kh.y = pk2(k8[2] * __expf(fminf(rf[2] - bs[2], 60.f)), k8[3] * __expf(fminf(rf[3] - bs[3], 60.f)));
                                kh.z = pk2(k8[4] * __expf(fminf(rf[4] - bs[4], 60.f)), k8[5] * __expf(fminf(rf[5] - bs[5], 60.f))); kh.w = pk2(k8[6] * __expf(fminf(rf[6] - bs[6], 60.f)), k8[7] * __expf(fminf(rf[7] - bs[7], 60.f)));
                                if (j == i) td = MFMA(qhf, __builtin_bit_cast(bf16x8, kh), td); else aa[j] = MFMA(qhf, __builtin_bit_cast(bf16x8, kh), aa[j]);
                            }
                        }
                    }
#pragma unroll
                    for (int r = 0; r < 4; ++r) { const int tl = 4 * fq + r; const bool keep = dir == 0 ? (fr <= tl) : (fr >= tl); td[r] = keep ? td[r] : 0.f; }
#pragma unroll
                    for (int j = 0; j < 8; ++j) if (j == i) aa[j] += td;
                }
                LBAR();
            }
#pragma unroll
            for (int j = 0; j < 8; ++j)
#pragma unroll
                for (int r = 0; r < 4; ++r) *(LAS bf16*)(AL + (16 * w + 4 * fq + r) * PIT + (16 * j + fr) * 2) = (bf16)f2bf(aa[j][r]);
            stage_vt128(VT, prow + 4608 + h * 128 + 32 * g, g, s);
            LBAR();
#pragma unroll
            for (int kk = 0; kk < 4; ++kk) { const bf16x8 a = ldsfrag(AL, 16 * w + fr, PIT, kk, fq);
#pragma unroll
                for (int ei = 0; ei < 8; ++ei) oa[ei] = MFMA(a, ldsfrag(VT, 16 * ei + fr, PIT, kk, fq), oa[ei]); }
            float rs[4];
#pragma unroll
            for (int r = 0; r < 4; ++r) { float q = 0.f;
#pragma unroll
                for (int ei = 0; ei < 8; ++ei) q += oa[ei][r] * oa[ei][r];
                rs[r] = 1.0f / sqrtf(sum16(q) * (1.0f / 128.0f) + NORM_EPS); }
            LBAR();
#pragma unroll
            for (int ei = 0; ei < 8; ++ei)
#pragma unroll
                for (int r = 0; r < 4; ++r) *(LAS bf16*)(lds + 69632 + (16 * w + 4 * fq + r) * PIT + (16 * ei + fr) * 2) = (bf16)f2bf(oa[ei][r] * rs[r]);
            LBAR();
            mix_store<128, 0>(lds + 69632, PIT, P + row0 * NP + 5120 + h * 128, C.hgrn_gn + layer * 512 + h * 128, MIX + row0 * D + 1024 + h * 128, tid);
            LBAR();
        } else if ((GRPMASK & 4) && grp == 2) {
            LAS unsigned char* QL = lds; LAS unsigned char* KL = lds + 34816; LAS unsigned char* AL = lds + 69632; LAS unsigned char* VT = lds + 104448;
            float bsc = 0.f, bet = 0.f;
            if (tid < 256) { const int dir = tid >> 7; const float* gp = WSP(float, WS_G16) + (row0 + s) * 16; const float* gb = C.mlstm_gate_b + layer * 16;
                bet = gp[4 * dir + h] + gb[4 * dir + h];
                bsc = scan_wave_sum(logsigmoidf_(gp[8 + 4 * dir + h] + gb[8 + 4 * dir + h]), lane, dir != 0); if (lane == (dir ? 0 : 63)) SC[1920 + w] = bsc; }
            for (int idx = tid; idx < 768; idx += NTHR) { const int j = idx >> 8, qk = (idx >> 7) & 1, dd = idx & 127; SC[2304 + idx] = C.mlstm_conv[(size_t)layer * 3072 + j * 1024 + qk * 512 + h * 128 + dd]; }
            LBAR();
            float pmx = 0.f;
            if (tid < 256) { const int dir = tid >> 7; if (dir == 0 ? (w == 1) : (w == 2)) bsc += SC[1920 + (w ^ 1)];
                bet -= bsc;
                pmx = scan_wave_max(bet, lane, dir != 0); if (lane == (dir ? 0 : 63)) SC[1928 + w] = pmx; }
            LBAR();
            if (tid < 256) { const int dir = tid >> 7; LAS float* Sd = SC + 1024 * dir; if (dir == 0 ? (w == 1) : (w == 2)) pmx = fmaxf(pmx, SC[1928 + (w ^ 1)]);
                const float m = WSP(float, WS_MSM)[(dir ? sidx_b : sidx_f)], mt = bsc + fmaxf(pmx, m);
                Sd[384 + s] = bet; Sd[512 + s] = bsc - mt; Sd[640 + s] = __expf(bsc + m - mt); Sd[768 + s] = __expf(-mt); }
            {
                const int tall = 128 * c + s, seg0 = c < 2 ? 0 : LC, seg1 = c < 2 ? LC : TB;
                const bool hp = tall - 1 >= seg0, hn = tall + 1 < seg1;
#pragma unroll
                for (int qk = 0; qk < 2; ++qk) { const bf16* xp = prow + 5632 + qk * 512 + h * 128 + 32 * g; const LAS float* cw = SC + 2304 + qk * 128 + 32 * g;
#pragma unroll
                    for (int q = 0; q < 4; ++q) { float a8[8], t8[8];
                        unpack8(*(const v4u*)(xp + 8 * q), t8);
#pragma unroll
                        for (int i = 0; i < 8; ++i) a8[i] = t8[i] * cw[256 + 8 * q + i];
                        if (hp) { unpack8(*(const v4u*)(xp - NP + 8 * q), t8);
#pragma unroll
                            for (int i = 0; i < 8; ++i) a8[i] += t8[i] * cw[8 * q + i]; }
                        if (hn) { unpack8(*(const v4u*)(xp + NP + 8 * q), t8);
#pragma unroll
                            for (int i = 0; i < 8; ++i) a8[i] += t8[i] * cw[512 + 8 * q + i]; }
                        const float sc = qk ? 0.08838834764831845f : 1.0f;
                        v4u o4; o4.x = pk2(siluf_(a8[0]) * sc, siluf_(a8[1]) * sc); o4.y = pk2(siluf_(a8[2]) * sc, siluf_(a8[3]) * sc); o4.z = pk2(siluf_(a8[4]) * sc, siluf_(a8[5]) * sc); o4.w = pk2(siluf_(a8[6]) * sc, siluf_(a8[7]) * sc);
                        *(LAS v4u*)((qk ? KL : QL) + s * PIT + (32 * g + 8 * q) * 2) = o4; } }
            }
            stage_vt128(VT, prow + 6656 + h * 128 + 32 * g, g, s);
            LBAR();
            bf16x8 qf[4];
#pragma unroll
            for (int kk = 0; kk < 4; ++kk) qf[kk] = ldsfrag(QL, 16 * w + fr, PIT, kk, fq);
            f32x4 sa[8], hs[8];
#pragma unroll
            for (int j = 0; j < 8; ++j) { sa[j] = (f32x4){0.f, 0.f, 0.f, 0.f}; hs[j] = (f32x4){0.f, 0.f, 0.f, 0.f}; }
#pragma unroll
            for (int kk = 0; kk < 4; ++kk)
#pragma unroll
                for (int j = 0; j < 8; ++j) sa[j] = MFMA(qf[kk], ldsfrag(KL, 16 * j + fr, PIT, kk, fq), sa[j]);
#pragma unroll 1
            for (int dir = 0; dir < 2; ++dir) {
                const LAS float* Sd = SC + 1024 * dir;
                float den[4] = {0.f, 0.f, 0.f, 0.f};
#pragma unroll
                for (int j = 0; j < 8; ++j) { const int ss = 16 * j + fr; const float be = Sd[384 + ss];
#pragma unroll
                    for (int r = 0; r < 4; ++r) { const int t = 16 * w + 4 * fq + r; const bool valid = dir == 0 ? (ss <= t) : (ss >= t);
                        const float wgt = valid ? __expf(fminf(Sd[512 + t] + be, 0.f)) : 0.f, a = sa[j][r] * wgt; den[r] += a;
                        *(LAS bf16*)(AL + t * PIT + ss * 2) = (bf16)f2bf(a); } }
#pragma unroll
                for (int r = 0; r < 4; ++r) den[r] = sum16(den[r]);
                f32x4 ia[9];
#pragma unroll
                for (int j = 0; j < 9; ++j) ia[j] = (f32x4){0.f, 0.f, 0.f, 0.f};
                const bf16* ST = WSP(bf16, WS_MST) + (dir ? sidx_b : sidx_f) * (144 * 128) + (size_t)fr * 128 + 8 * fq;
                LDS_WAIT();
#pragma unroll
                for (int kk = 0; kk < 4; ++kk) {
#pragma unroll
                    for (int ei = 0; ei < 9; ++ei) { const bf16x8 bb = *(const bf16x8*)(ST + ei * 2048 + 32 * kk); ia[ei] = MFMA(qf[kk], bb, ia[ei]); }
                    __builtin_amdgcn_sched_barrier(0); }
                float inv[4];
#pragma unroll
                for (int r = 0; r < 4; ++r) { const int t = 16 * w + 4 * fq + r; const float wi = Sd[640 + t];
                    const float qn = __shfl(ia[8][r], lane & 48);
                    const float dt = den[r] + wi * qn; inv[r] = 1.0f / fmaxf(fabsf(dt), Sd[768 + t]);
#pragma unroll
                    for (int ei = 0; ei < 8; ++ei) ia[ei][r] *= wi; }
#pragma unroll
                for (int kk = 0; kk < 4; ++kk) { const bf16x8 a = ldsfrag(AL, 16 * w + fr, PIT, kk, fq);
#pragma unroll
                    for (int ei = 0; ei < 8; ++ei) ia[ei] = MFMA(a, ldsfrag(VT, 16 * ei + fr, PIT, kk, fq), ia[ei]);
                    __builtin_amdgcn_sched_barrier(0); }
#pragma unroll
                for (int r = 0; r < 4; ++r)
#pragma unroll
                    for (int ei = 0; ei < 8; ++ei) hs[ei][r] += ia[ei][r] * inv[r];
                LDS_WAIT();
            }
            float mean[4], rs[4];
#pragma unroll
            for (int r = 0; r < 4; ++r) { float q = 0.f;
#pragma unroll
                for (int ei = 0; ei < 8; ++ei) q += hs[ei][r];
                mean[r] = sum16(q) * (1.0f / 128.0f); float q2 = 0.f;
#pragma unroll
                for (int ei = 0; ei < 8; ++ei) { const float dlt = hs[ei][r] - mean[r]; q2 += dlt * dlt; }
                rs[r] = 1.0f / sqrtf(sum16(q2) * (1.0f / 128.0f) + NORM_EPS); }
            LBAR();
#pragma unroll
            for (int ei = 0; ei < 8; ++ei)
#pragma unroll
                for (int r = 0; r < 4; ++r) *(LAS bf16*)(lds + (16 * w + 4 * fq + r) * PIT + (16 * ei + fr) * 2) = (bf16)f2bf((hs[ei][r] - mean[r]) * rs[r]);
            LBAR();
            mix_store<128, 1>(lds, PIT, P + row0 * NP + 7168 + h * 128, C.mlstm_gn + layer * 512 + h * 128, MIX + row0 * D + 1536 + h * 128, tid);
            LBAR();
        }
    }
}
struct Args { const float* in[23]; float* out; unsigned char* ws; int ph_lo, ph_hi; };
__device__ __forceinline__ void moe_tables(const Ctx& C, LAS int* tab, int NT) {
    __syncthreads();
    if (C.tid == 0) { int cnt[8], off[9]; expert_offsets(C, cnt, off);
#pragma unroll
        for (int e = 0; e < 8; ++e) { tab[e] = (off[e + 1] - off[e]) >> 8; tab[8 + e] = off[e] >> 8; tab[16 + e] = off[e] >> 8; }
        tab[24] = off[8] >> 8; }
    __syncthreads();
    if (C.tid < 16) { const int l = C.tid * C.G + C.bx;
        if (l < tab[24] * NT) { int e = 0;
#pragma unroll
            for (int j = 1; j < 8; ++j) if (l >= tab[16 + j] * NT) e = j;
            const int idx = l - tab[16 + e] * NT, te = tab[e], pml = idx % te, pnl = idx / te;
            tab[32 + 4 * C.tid] = tab[8 + e] + pml; tab[33 + 4 * C.tid] = e * NT + pnl; tab[34 + 4 * C.tid] = pnl; } }
    __syncthreads();
}
typedef const __attribute__((address_space(4))) Args* KArgs;
__device__ __forceinline__ Ctx make_ctx(unsigned char* lds_raw) {
    KArgs ka = (KArgs)__builtin_amdgcn_kernarg_segment_ptr(); asm volatile("" : "+s"(ka));
    Ctx C;
    C.lds = (LAS unsigned char*)lds_raw;
    C.tid = threadIdx.x; C.lane = C.tid & 63; C.wave = __builtin_amdgcn_readfirstlane(C.tid >> 6); C.G = gridDim.x; C.bx = blockIdx.x;
    C.x = ka->in[0]; C.c = ka->in[1]; C.ctx = ka->in[2]; C.c_ctx = ka->in[3]; C.w_ada = ka->in[4]; C.b_ada = ka->in[5]; C.norm_g = ka->in[6]; C.w_in = ka->in[7]; C.w_out = ka->in[8];
    C.ret_decay = ka->in[9]; C.ret_gn = ka->in[10]; C.hgrn_lb = ka->in[11]; C.hgrn_gn = ka->in[12]; C.mlstm_conv = ka->in[13]; C.mlstm_gate_b = ka->in[14]; C.mlstm_gn = ka->in[15];
    C.w_ffn1 = ka->in[16]; C.w_ffn3 = ka->in[17]; C.w_ffn2 = ka->in[18]; C.w_router = ka->in[19]; C.w_exp1 = ka->in[20]; C.w_exp3 = ka->in[21]; C.w_exp2 = ka->in[22];
    C.out = ka->out; C.ws = ka->ws;
    return C;
}
#ifndef PHMASK
#define PHMASK 0xFFFFF
#endif
#define IN(k) (lo <= (k) && (k) < hi)
#define EN(n) ((PHMASK >> (n)) & 1)
#define SEAM(k) do { if (!MK_PER_PHASE && IN(k) && IN((k) + 1)) xcd_barrier(bar); } while (0)
#define MKCTX() const Ctx C = make_ctx(lds_raw)
#ifndef REPMASK
#define REPMASK 0
#endif
#define REP(n) _Pragma("unroll 1") for (int rep_ = 0; rep_ <= ((REPMASK >> (n)) & 1); ++rep_)
template <int layer> __device__ __forceinline__ void layer_phases(unsigned char* lds_raw, LAS int* TAB, const XcdBarrier& bar, const int lo, const int hi) {
    using namespace pg8;
        const int base = 2 + 9 * layer;
        if (EN(2) && IN(base + 0)) { MKCTX();
            Gemm g{WSP(bf16, WS_H), WSP(bf16, WS_WIN) + (size_t)layer * NP * D, TT, NP, D}; TileOrder S; S.init_static(TT, NP, C.G, C.bx);
            EpiProj E{WSP(bf16, WS_P), NP, WSP(float, WS_LF), C.hgrn_lb, layer};
            REP(2) gemm_phase<EpiProj, TileOrder, true, true>(C.lds, g, S, E);
            SEAM(base + 0);
        }
        if (EN(3) && IN(base + 1)) { REP(3) { MKCTX(); phase_state(C, layer, rep_); } SEAM(base + 1); }
        if (EN(4) && IN(base + 2)) { REP(4) { MKCTX(); phase_out(C, layer, rep_); } SEAM(base + 2); }
        if (EN(5) && IN(base + 3)) { MKCTX();
            Gemm g{WSP(bf16, WS_MIX), WSP(bf16, WS_WOUT) + (size_t)layer * D * D, TT, D, D}; TileOrder S;
            if (layer == 0) S.init_static(TT, D, C.G, C.bx); else S.init_latent(C.G, C.bx);
            EpiF32 E{WSP(float, WS_Y), D};
            REP(5) gemm_phase<EpiF32, TileOrder, true, true>(C.lds, g, S, E);
            SEAM(base + 3);
        }
        if (EN(6) && IN(base + 4)) { MKCTX(); row_phase<1>(C, layer); SEAM(base + 4); }
        if (EN(7) && IN(base + 5)) { MKCTX(); if (layer == 1) phase_gather(C); SEAM(base + 5); }
        if (EN(8) && IN(base + 6)) { MKCTX();
            if (layer == 0) { Gemm g{WSP(bf16, WS_H), WSP(bf16, WS_WF13), TT, 2 * DFF, D}; TileOrder S; S.init_static(TT, 2 * DFF, C.G, C.bx);
                EpiSwiGLU E{WSP(bf16, WS_U), DFF};
                REP(8) gemm_phase<EpiSwiGLU, TileOrder, true, true>(C.lds, g, S, E);
            } else { moe_tables(C, TAB, 44); Gemm g{WSP(bf16, WS_HG), WSP(bf16, WS_WE13), 0, 2 * DFF, D / 2}; TileOrder S; S.init_moe(TAB, 44, C.G, C.bx);
                EpiSwiGLUF8 E{SB_W13, SB_X8, WSP(unsigned char, WS_U), DFF, U8_SCALE};
                REP(8) gemm_phase<EpiSwiGLUF8, TileOrder, true, true>(C.lds, g, S, E);
            }
            SEAM(base + 6);
        }
        if (EN(9) && IN(base + 7)) { MKCTX();
            if (layer == 0) { Gemm g{WSP(bf16, WS_U), WSP(bf16, WS_WF2), TT, D, DFF}; TileOrder S; S.init_static(TT, D, C.G, C.bx); EpiF32 E{WSP(float, WS_Y), D};
                REP(9) gemm_phase<EpiF32, TileOrder, true, true>(C.lds, g, S, E);
            } else { moe_tables(C, TAB, 8); Gemm g{WSP(bf16, WS_U), WSP(bf16, WS_WE2), 0, D, DFF / 2}; TileOrder S; S.init_moe(TAB, 8, C.G, C.bx); EpiF32F8 E{WSP(float, WS_YS), D, SB_W2, SB_X8};
                REP(9) gemm_phase<EpiF32F8, TileOrder, true, true>(C.lds, g, S, E);
            }
            SEAM(base + 7);
        }
        if (EN(10) && IN(base + 8)) { MKCTX(); if (layer == 0) row_phase<2>(C, 0); else row_phase<3>(C, 1); SEAM(base + 8); }
}
__global__ void __launch_bounds__(NTHR, 2) fwd_kernel(Args args) {
    extern __shared__ __attribute__((aligned(16))) unsigned char lds_raw[];
    volatile LAS unsigned* MISC = (volatile LAS unsigned*)((LAS unsigned char*)lds_raw + MISC_OFF);
    LAS int* TAB = (LAS int*)((LAS unsigned char*)lds_raw + MISC_OFF + 64);
    if (threadIdx.x < 128) MISC[threadIdx.x] = 0u;
    __syncthreads();
    XcdBarrier bar; bar.bar = (unsigned*)(args.ws + WS_CTL) + CW_BAR; bar.x = 0; bar.st = nullptr;
    if (!MK_PER_PHASE) bar = xcd_barrier_post((unsigned*)(args.ws + WS_CTL) + CW_BAR, MISC);
    const int lo = args.ph_lo, hi = args.ph_hi;
    using namespace pg8;
    if (EN(0) && IN(0)) { REP(0) { MKCTX(); phase_prologue(C); } SEAM(0); }
    if (EN(1) && IN(1)) { MKCTX(); row_phase<0>(C, 0); SEAM(1); }
    layer_phases<0>(lds_raw, TAB, bar, lo, hi);
    layer_phases<1>(lds_raw, TAB, bar, lo, hi);
#undef IN
#undef SEAM
}

extern "C" void kernel_launch(void* const* d_in, const int* in_sizes, int n_in, void* d_out, int out_size, void* d_ws, size_t ws_size, hipStream_t stream) {
    static int grid = 0;
    if (grid == 0) {
        if (n_in != 23 || out_size != NB * SEQ * D || ws_size < WS_END) { fprintf(stderr, "kernel_launch: unexpected shapes (n_in %d, out %d, ws %zu < %zu); nothing launched\n", n_in, out_size, ws_size, (size_t)WS_END); grid = -1; return; }
        int dev = 0, cus = 0, per_cu = 0;
        if (hipGetDevice(&dev) != hipSuccess || hipDeviceGetAttribute(&cus, hipDeviceAttributeMultiprocessorCount, dev) != hipSuccess) { grid = -1; return; }
        if (hipFuncSetAttribute((const void*)fwd_kernel, hipFuncAttributeMaxDynamicSharedMemorySize, LDS_BYTES) != hipSuccess) { fprintf(stderr, "kernel_launch: hipFuncSetAttribute failed\n"); grid = -1; return; }
        if (hipOccupancyMaxActiveBlocksPerMultiprocessor(&per_cu, (const void*)fwd_kernel, NTHR, LDS_BYTES) != hipSuccess || per_cu < 1) fprintf(stderr, "kernel_launch: occupancy query reports %d\n", per_cu);
        (void)hipGetLastError();
        grid = cus;
    }
    if (grid < 0) return;
    (void)hipMemsetAsync((char*)d_ws + WS_CTL, 0, CTL_ZERO_BYTES, stream);
    Args a{};
    for (int i = 0; i < 23; ++i) a.in[i] = (const float*)d_in[i];
    a.out = (float*)d_out; a.ws = (unsigned char*)d_ws;
#if MK_PER_PHASE
    for (int p = 0; p < N_PHASES; ++p) { if (p == 7) continue; a.ph_lo = p; a.ph_hi = p + 1; hipLaunchKernelGGL(fwd_kernel, dim3(grid), dim3(NTHR), LDS_BYTES, stream, a); }
#else
    a.ph_lo = 0; a.ph_hi = N_PHASES; hipLaunchKernelGGL(fwd_kernel, dim3(grid), dim3(NTHR), LDS_BYTES, stream, a);
#endif
}
```
